# Optimizing an MI355X kernel written in HIP

```python
import math
import jax, jax.numpy as jnp
from jax import lax
import numpy as np

D_MODEL = 4096
BATCH = 4
SEQ = 4096
DEPTH = 1

ATTN_HEADS = 8
ATTN_HEAD_DIM = 128
ATTN_WIDTH = ATTN_HEADS * 2 * ATTN_HEAD_DIM
CONV_WIDTH = D_MODEL - ATTN_WIDTH
CONV_GROUPS = 16
CONV_K = 3
IN_WIDTH = 3 * ATTN_WIDTH + 3 * CONV_WIDTH
D_FF = 11008
ROPE_THETA = 10000.0
Q_BLOCK = 128
EPS = 1e-6
N_MOD = 6

kernel_name = "hybrid_diffattn_shortconv_convffn_block"


def rmsnorm(x, g):
    xf = x.astype(jnp.float32)
    y = xf * lax.rsqrt(jnp.mean(xf * xf, axis=-1, keepdims=True) + EPS) * g.astype(jnp.float32)
    return y.astype(x.dtype)


def causal_dwconv(x, w):
    k = w.shape[0]
    s = x.shape[1]
    xp = jnp.pad(x, ((0, 0), (k - 1, 0), (0, 0)))
    y = xp[:, 0:s] * w[0]
    for j in range(1, k):
        y = y + xp[:, j:j + s] * w[j]
    return y


def rope_tables(positions, dim):
    inv_freq = ROPE_THETA ** (-jnp.arange(0, dim, 2, dtype=jnp.float32) / dim)
    ang = positions.astype(jnp.float32)[..., None] * inv_freq
    ang = jnp.concatenate([ang, ang], axis=-1)
    return jnp.cos(ang), jnp.sin(ang)


def apply_rope(t, cos, sin):
    cos = cos[:, :, None, None, :].astype(t.dtype)
    sin = sin[:, :, None, None, :].astype(t.dtype)
    half = t.shape[-1] // 2
    rot = jnp.concatenate([-t[..., half:], t[..., :half]], axis=-1)
    return t * cos + rot * sin


def diff_attention(q, k, v, lam):
    b, s, h, _, d = q.shape
    nb = s // Q_BLOCK
    scale = d ** -0.5
    qb = q.reshape(b, nb, Q_BLOCK, h, 2, d).transpose(1, 0, 2, 3, 4, 5)
    kpos = jnp.arange(s)

    def one_block(args):
        qi, i = args
        sc = jnp.einsum('bqhcd,bkhcd->bchqk', qi, k).astype(jnp.float32) * scale
        qpos = i * Q_BLOCK + jnp.arange(Q_BLOCK)
        mask = kpos[None, :] <= qpos[:, None]
        sc = jnp.where(mask, sc, jnp.finfo(jnp.float32).min)
        p = jax.nn.softmax(sc, axis=-1)
        a = p[:, 0] - lam * p[:, 1]
        return jnp.einsum('bhqk,bkhe->bqhe', a.astype(v.dtype), v)

    out = lax.map(one_block, (qb, jnp.arange(nb)))
    return out.transpose(1, 0, 2, 3, 4).reshape(b, s, h, 2 * d)


def setup_inputs(seed: int = 0) -> dict:
    key = jax.random.key(seed)
    ks = jax.random.split(key, 20)
    f32 = jnp.float32
    nrm = lambda k, shape, s: jax.random.normal(k, shape, f32) * s
    x = jax.random.normal(ks[0], (BATCH, SEQ, D_MODEL), f32)
    c = jax.random.normal(ks[1], (BATCH, D_MODEL), f32)
    offset = jax.random.randint(ks[2], (BATCH,), 0, 1024, dtype=jnp.int32)
    positions = offset[:, None] + jnp.arange(SEQ, dtype=jnp.int32)[None, :]
    return {
        "x": x,
        "c": c,
        "positions": positions,
        "w_ada": nrm(ks[3], (DEPTH, D_MODEL, N_MOD * D_MODEL), D_MODEL ** -0.5),
        "b_ada": nrm(ks[4], (DEPTH, N_MOD * D_MODEL), 0.02),
        "g_pre_mix": 1.0 + nrm(ks[5], (DEPTH, D_MODEL), 0.02),
        "g_post_mix": 1.0 + nrm(ks[6], (DEPTH, D_MODEL), 0.02),
        "w_in": nrm(ks[7], (DEPTH, D_MODEL, IN_WIDTH), D_MODEL ** -0.5),
        "lambda_q1": nrm(ks[8], (DEPTH, ATTN_HEAD_DIM), 0.1),
        "lambda_k1": nrm(ks[9], (DEPTH, ATTN_HEAD_DIM), 0.1),
        "lambda_q2": nrm(ks[10], (DEPTH, ATTN_HEAD_DIM), 0.1),
        "lambda_k2": nrm(ks[11], (DEPTH, ATTN_HEAD_DIM), 0.1),
        "g_subln": 1.0 + nrm(ks[12], (DEPTH, 2 * ATTN_HEAD_DIM), 0.02),
        "w_conv_mix": nrm(ks[13], (DEPTH, CONV_K, CONV_WIDTH), CONV_K ** -0.5),
        "w_out": nrm(ks[14], (DEPTH, D_MODEL, D_MODEL), D_MODEL ** -0.5),
        "g_pre_ffn": 1.0 + nrm(ks[15], (DEPTH, D_MODEL), 0.02),
        "g_post_ffn": 1.0 + nrm(ks[16], (DEPTH, D_MODEL), 0.02),
        "w_up": nrm(ks[17], (DEPTH, D_MODEL, 2 * D_FF), D_MODEL ** -0.5),
        "w_conv_ffn": nrm(ks[18], (DEPTH, CONV_K, 2 * D_FF), CONV_K ** -0.5),
        "w_down": nrm(ks[19], (DEPTH, D_FF, D_MODEL), D_FF ** -0.5),
    }


def reference(x, c, positions, w_ada, b_ada, g_pre_mix, g_post_mix, w_in, lambda_q1, lambda_k1,
              lambda_q2, lambda_k2, g_subln, w_conv_mix, w_out, g_pre_ffn, g_post_ffn, w_up,
              w_conv_ffn, w_down):
    b, s, _ = x.shape
    cos, sin = rope_tables(positions, ATTN_HEAD_DIM)
    cond = jax.nn.silu(c)
    a_w, c_w = ATTN_WIDTH, CONV_WIDTH
    splits = [a_w, 2 * a_w, 3 * a_w, 3 * a_w + c_w, 3 * a_w + 2 * c_w]
    for l in range(DEPTH):
        lam_init = 0.8 - 0.6 * math.exp(-0.3 * l)
        mod = jnp.einsum('bd,de->be', cond, w_ada[l]) + b_ada[l]
        sh1, sc1, gt1, sh2, sc2, gt2 = [m[:, None, :] for m in jnp.split(mod, N_MOD, axis=-1)]

        h = rmsnorm(x, g_pre_mix[l]) * (1.0 + sc1) + sh1
        proj = jnp.einsum('bsd,de->bse', h, w_in[l])
        q, k, v, gate_b, gate_c, hc = jnp.split(proj, splits, axis=-1)

        q = apply_rope(q.reshape(b, s, ATTN_HEADS, 2, ATTN_HEAD_DIM), cos, sin)
        k = apply_rope(k.reshape(b, s, ATTN_HEADS, 2, ATTN_HEAD_DIM), cos, sin)
        v = v.reshape(b, s, ATTN_HEADS, 2 * ATTN_HEAD_DIM)
        lam = (jnp.exp(jnp.sum(lambda_q1[l].astype(jnp.float32) * lambda_k1[l].astype(jnp.float32)))
               - jnp.exp(jnp.sum(lambda_q2[l].astype(jnp.float32) * lambda_k2[l].astype(jnp.float32)))
               + lam_init)
        attn = diff_attention(q, k, v, lam)
        attn = (rmsnorm(attn, g_subln[l]) * (1.0 - lam_init)).reshape(b, s, a_w)

        conv = gate_b * causal_dwconv(gate_c * hc, w_conv_mix[l])

        mixed = jnp.concatenate([attn.astype(conv.dtype), conv], axis=-1)
        y = jnp.einsum('bse,ed->bsd', mixed, w_out[l])
        x = x + gt1 * rmsnorm(y, g_post_mix[l])

        h2 = rmsnorm(x, g_pre_ffn[l]) * (1.0 + sc2) + sh2
        u = causal_dwconv(jnp.einsum('bsd,df->bsf', h2, w_up[l]), w_conv_ffn[l])
        u_gate, u_val = jnp.split(u, 2, axis=-1)
        f = jnp.einsum('bsf,fd->bsd', jax.nn.silu(u_gate) * u_val, w_down[l])
        x = x + gt2 * rmsnorm(f, g_post_ffn[l])
    return x
```

```cpp
#include <hip/hip_runtime.h>
#include <hip/hip_bf16.h>
#include <cstdio>
#include <cstdint>
__device__ __forceinline__ int opaque_tid() { int t; asm volatile("v_mov_b32 %0, %1" : "=v"(t) : "v"(threadIdx.x)); return t; }
namespace pg8 {
#define PG8_LAS __attribute__((address_space(3)))
typedef unsigned short bf16_t;
typedef short bf16x8 __attribute__((ext_vector_type(8)));
typedef float f32x4 __attribute__((ext_vector_type(4)));
typedef unsigned u32x4 __attribute__((ext_vector_type(4)));
constexpr int BM = 256, BK = 64, HALF = 128, HTB = HALF * BK * 2  , STAGE_BYTES = 8 * HTB, NXCD = 8, WGM = 8;

__host__ __device__ __forceinline__ int lds_byte(int r, int c) { const int st = (r >> 4) * 2 + (c >> 5), rr = r & 15, cc = c & 31, ob = rr * 64 + cc * 2; return st * 1024 + (ob ^ (((ob >> 9) & 1) << 5)); }
__host__ __device__ __forceinline__ void stage_rc(int b, int& R, int& C) { const int st = b / 1024, sb = b % 1024, swz = sb ^ (((sb >> 9) & 1) << 5); R = (st >> 1) * 16 + swz / 64; C = (st & 1) * 32 + (swz % 64) / 2; }
__host__ __device__ __forceinline__ int perm32(int rho) { const int n = rho >> 4, i = rho & 15; return 8 * (i >> 2) + 4 * n + (i & 3); }

struct Unit { int pm, pn; };
struct Gemm { const bf16_t* A; const bf16_t* Bt; int M, N, K; };

struct StaticOrder {
    int nM, nN, nwg, G, c;
    __host__ __device__ void init(int M, int N, int G_, int c_) { nM = M / BM; nN = N / BM; nwg = nM * nN; G = G_; c = c_; }
    __host__ __device__ bool next(int i, Unit& u) const {
        const long L = (long)i * G + c; if (L >= nwg) return false;
        int wgid = (int)L; { const int q = nwg / NXCD, r = nwg % NXCD, xcd = wgid % NXCD, off = wgid / NXCD; wgid = (xcd < r ? xcd * (q + 1) : r * (q + 1) + (xcd - r) * q) + off; }
        const int nig = WGM * nN, gid = wgid / nig, fm = gid * WGM, gsz = (nM - fm) < WGM ? (nM - fm) : WGM;
        u.pm = fm + ((wgid % nig) % gsz); u.pn = (wgid % nig) / gsz; return true;
    }
    __device__ __forceinline__ void a_ready(const Unit&) const {}
    __device__ __forceinline__ void done(const Unit&) const {}
};

__device__ __forceinline__ unsigned cvt_pk_bf16(float lo, float hi) { unsigned r; asm volatile("v_cvt_pk_bf16_f32 %0, %1, %2" : "=v"(r) : "v"(lo), "v"(hi)); return r; }
typedef float f32x2 __attribute__((ext_vector_type(2)));
constexpr int EP_M = 16384, EP_SECW = 2048, EP_DFF = 11008, EP_UPW = 22016;
constexpr size_t EP_SEC = (size_t)EP_M * EP_SECW;
__device__ __forceinline__ u32x4 pack8(const f32x4 a, const f32x4 b) { u32x4 w; w.x = cvt_pk_bf16(a[0], a[1]); w.y = cvt_pk_bf16(a[2], a[3]); w.z = cvt_pk_bf16(b[0], b[1]); w.w = cvt_pk_bf16(b[2], b[3]); return w; }

struct EpiProj {
    static constexpr bool PERM = true, AFTER_DRAIN = false;
    bf16_t* out; const float* cosT; const float* sinT;
    __device__ __forceinline__ void operator()(const f32x4 (&acc)[2][2][4][2], const Unit& u, int wr, int wc, int fr, int fq) const {
        const int t = u.pn >> 3;
        bf16_t* base = out + (size_t)t * EP_SEC;
        const int row0 = u.pm * BM + wr * 64 + fr, col0 = (u.pn & 7) * BM + wc * 32 + 8 * fq;
        if (t < 2) {
            const int d0 = 16 * wc + 4 * fq;
#pragma unroll
            for (int ai = 0; ai < 2; ++ai)
#pragma unroll
                for (int m = 0; m < 4; ++m) { const int row = row0 + ai * HALF + m * 16;
                    const f32x4 cs = *(const f32x4*)(cosT + (size_t)row * 64 + d0), sn = *(const f32x4*)(sinT + (size_t)row * 64 + d0);
#pragma unroll
                    for (int bj = 0; bj < 2; ++bj) { const f32x4 t0 = acc[ai][bj][m][0], t1 = acc[ai][bj][m][1];
                        const f32x4 lo = t0 * cs - t1 * sn, hi = t1 * cs + t0 * sn;
                        *(u32x4*)(base + (size_t)row * EP_SECW + col0 + bj * HALF) = pack8(lo, hi); } }
        } else {
#pragma unroll
            for (int ai = 0; ai < 2; ++ai)
#pragma unroll
                for (int m = 0; m < 4; ++m) { const int row = row0 + ai * HALF + m * 16;
#pragma unroll
                    for (int bj = 0; bj < 2; ++bj) *(u32x4*)(base + (size_t)row * EP_SECW + col0 + bj * HALF) = pack8(acc[ai][bj][m][0], acc[ai][bj][m][1]); }
        }
    }
};

struct EpiF32SS {
    static constexpr bool PERM = false, AFTER_DRAIN = false;
    float* C; int ldc; float* ss;
    __device__ __forceinline__ void operator()(const f32x4 (&acc)[2][2][4][2], const Unit& u, int wr, int wc, int fr, int fq) const {
        const int row0 = u.pm * BM + wr * 64 + fr, col0 = u.pn * BM + wc * 32 + 4 * fq;
#pragma unroll
        for (int ai = 0; ai < 2; ++ai)
#pragma unroll
            for (int m = 0; m < 4; ++m) { const int row = row0 + ai * HALF + m * 16; float* rowp = C + (size_t)row * ldc + col0; float s = 0.f;
#pragma unroll
                for (int bj = 0; bj < 2; ++bj)
#pragma unroll
                    for (int n = 0; n < 2; ++n) { const f32x4 v = acc[ai][bj][m][n]; *(f32x4*)(rowp + bj * HALF + n * 16) = v; s += (v[0] * v[0] + v[1] * v[1]) + (v[2] * v[2] + v[3] * v[3]); }
                s += __shfl_xor(s, 16); s += __shfl_xor(s, 32);
                if (fq == 0) ss[(size_t)row * 64 + u.pn * 4 + wc] = s; }
    }
};

__device__ __forceinline__ float silu_f(float x) { return x * __builtin_amdgcn_rcpf(1.0f + __builtin_amdgcn_exp2f(x * -1.4426950408889634f)); }
struct EpiUp {
    static constexpr bool PERM = true, AFTER_DRAIN = false;
    bf16_t* G; const float* wconv; float* edge;
    __device__ __forceinline__ void operator()(const f32x4 (&acc)[2][2][4][2], const Unit& u, int wr, int wc, int fr, int fq) const {
        const int lane = fq * 16 + fr;
        const int f0 = u.pn * 128 + wc * 32 + 8 * fq;
        const int ce = u.pn * 256 + wc * 32 + 8 * fq;
        const int src1 = (lane & 48) | ((fr + 15) & 15), src2 = (lane & 48) | ((fr + 14) & 15);
        unsigned keep[2][4][2];
#pragma unroll
        for (int n = 0; n < 2; ++n) {
            f32x4 wg[3], wv[3];
#pragma unroll
            for (int j = 0; j < 3; ++j) { wg[j] = *(const f32x4*)(wconv + (size_t)j * EP_UPW + f0 + 4 * n); wv[j] = *(const f32x4*)(wconv + (size_t)j * EP_UPW + EP_DFF + f0 + 4 * n); }
#pragma unroll
            for (int ai = 0; ai < 2; ++ai) {
                const int blk = u.pm * 4 + ai * 2 + wr;
                f32x4 pg1 = (f32x4){0.f, 0.f, 0.f, 0.f}, pg2 = pg1, pv1 = pg1, pv2 = pg1;
#pragma unroll
                for (int m = 0; m < 4; ++m) {
                    const f32x4 g = acc[ai][0][m][n], v = acc[ai][1][m][n];
                    f32x4 rg1, rg2, rv1, rv2;
#pragma unroll
                    for (int j = 0; j < 4; ++j) { rg1[j] = __shfl(g[j], src1); rg2[j] = __shfl(g[j], src2); rv1[j] = __shfl(v[j], src1); rv2[j] = __shfl(v[j], src2); }
                    const f32x4 g1 = fr >= 1 ? rg1 : pg1, g2 = fr >= 2 ? rg2 : pg2, v1 = fr >= 1 ? rv1 : pv1, v2 = fr >= 2 ? rv2 : pv2;
                    pg1 = rg1; pg2 = rg2; pv1 = rv1; pv2 = rv2;
                    const f32x4 cg = wg[2] * g + wg[1] * g1 + wg[0] * g2, cv = wv[2] * v + wv[1] * v1 + wv[0] * v2;
                    f32x4 o;
#pragma unroll
                    for (int j = 0; j < 4; ++j) o[j] = silu_f(cg[j]) * cv[j];
                    const unsigned w0 = cvt_pk_bf16(o[0], o[1]), w1 = cvt_pk_bf16(o[2], o[3]);
                    if (n == 0) { keep[ai][m][0] = w0; keep[ai][m][1] = w1; }
                    else { const int row = u.pm * BM + ai * HALF + wr * 64 + m * 16 + fr;
                        if (m > 0 || fr >= 2) { u32x4 w; w.x = keep[ai][m][0]; w.y = keep[ai][m][1]; w.z = w0; w.w = w1; *(u32x4*)(G + (size_t)row * EP_DFF + f0) = w; } }
                    if (m == 0 && fr < 2) { float* e = edge + ((size_t)blk * 4 + 2 + fr) * EP_UPW + ce + 4 * n; *(f32x4*)e = g; *(f32x4*)(e + 128) = v; }
                    if (m == 3 && fr >= 14 && blk + 1 < 256) { float* e = edge + ((size_t)(blk + 1) * 4 + (fr - 14)) * EP_UPW + ce + 4 * n; *(f32x4*)e = g; *(f32x4*)(e + 128) = v; }
                }
            }
        }
    }
};

template <class Epi, class Sched, bool ALIGN_EPI = false, bool SP2 = false>
__device__ __forceinline__ void gemm_phase(PG8_LAS unsigned char* lds, const Gemm g, const Sched& S, const Epi& E) {
    const int tid = opaque_tid(), wid = __builtin_amdgcn_readfirstlane(tid >> 6), lane = tid & 63, wr = wid >> 2, wc = wid & 3, fr = lane & 15, fq = lane >> 4;
    const int K = g.K, nt = K / BK;
    unsigned voffA[2], voffB[2];
#pragma unroll
    for (int i = 0; i < 2; ++i) { int R, C; stage_rc(tid * 16 + i * 8192, R, C); const int Rb = Epi::PERM ? ((R & ~31) + perm32(R & 31)) : R;
        voffA[i] = (unsigned)(R * K + C) * 2u; voffB[i] = (unsigned)(Rb * K + C) * 2u; }
    const size_t kstep = (size_t)(BK * 2);
    const size_t hstep = (size_t)HALF * K * 2;
    const size_t tstep = 2 * hstep;
    const unsigned ldsw = (unsigned)wid * 1024u;
    const int aoff = lds_byte(wr * 64 + fr, fq * 8), boff = lds_byte(wc * 32 + fr, fq * 8);
#define PG8_SA(b, h) (((b) * 2 + (h)) * HTB)
#define PG8_SB(b, h) ((4 + (b) * 2 + (h)) * HTB)
#define PG8_STAGE(bufoff, gbase, voff) do { _Pragma("unroll") for (int _i = 0; _i < 2; ++_i) \
        __builtin_amdgcn_global_load_lds((const unsigned*)((const char*)(gbase) + (voff)[_i]), (PG8_LAS unsigned*)(lds + (bufoff) + ldsw + _i * 8192), 16, 0, 0); } while (0)
#define PG8_LDA(dst, b, h) do { _Pragma("unroll") for (int m = 0; m < 4; ++m) _Pragma("unroll") for (int k = 0; k < 2; ++k) dst[m][k] = *(const PG8_LAS bf16x8*)(lds + PG8_SA(b, h) + aoff + m * 2048 + k * 1024); } while (0)
#define PG8_LDB(dst, b, h) do { _Pragma("unroll") for (int n = 0; n < 2; ++n) _Pragma("unroll") for (int k = 0; k < 2; ++k) dst[n][k] = *(const PG8_LAS bf16x8*)(lds + PG8_SB(b, h) + boff + n * 2048 + k * 1024); } while (0)
#define PG8_MMA(ai, bj, At, Bt) do { __builtin_amdgcn_s_setprio(1); _Pragma("unroll") for (int m = 0; m < 4; ++m) _Pragma("unroll") for (int n = 0; n < 2; ++n) _Pragma("unroll") for (int k = 0; k < 2; ++k) \
        acc[ai][bj][m][n] = __builtin_amdgcn_mfma_f32_16x16x32_bf16(Bt[n][k], At[m][k], acc[ai][bj][m][n], 0, 0, 0); __builtin_amdgcn_s_setprio(0); } while (0)
#define PG8_WAIT_V(n) asm volatile("s_waitcnt vmcnt(" #n ")" ::: "memory")
#define PG8_WAIT_L(n) asm volatile("s_waitcnt lgkmcnt(" #n ")" ::: "memory")
#define PG8_BAR __builtin_amdgcn_s_barrier()
#define PG8_SCHED __builtin_amdgcn_sched_barrier(0)
    Unit cur, nxt; int ui = 0;
    if (!S.next(0, cur)) return;
    f32x4 acc[2][2][4][2];
#pragma unroll
    for (int a = 0; a < 2; ++a)
#pragma unroll
        for (int b = 0; b < 2; ++b)
#pragma unroll
            for (int m = 0; m < 4; ++m)
#pragma unroll
                for (int n = 0; n < 2; ++n) acc[a][b][m][n] = (f32x4){0.f, 0.f, 0.f, 0.f};
    bf16x8 At[4][2], B0[2][2], B1[2][2];
    const char* cA = (const char*)g.A + (size_t)cur.pm * tstep; const char* cB = (const char*)g.Bt + (size_t)cur.pn * tstep;
    S.a_ready(cur);
    if constexpr (SP2) {
        PG8_STAGE(PG8_SB(0, 0), cB, voffB); PG8_STAGE(PG8_SB(0, 1), cB + hstep, voffB); PG8_STAGE(PG8_SA(0, 0), cA, voffA); PG8_STAGE(PG8_SA(0, 1), cA + hstep, voffA);
        if (wr == 1) PG8_BAR;
        PG8_WAIT_V(2); PG8_BAR;
        PG8_STAGE(PG8_SB(1, 0), cB + kstep, voffB); PG8_STAGE(PG8_SA(1, 0), cA + kstep, voffA); PG8_STAGE(PG8_SB(1, 1), cB + hstep + kstep, voffB);
        PG8_WAIT_V(6); PG8_BAR;
    } else {
        PG8_STAGE(PG8_SB(0, 0), cB, voffB); PG8_STAGE(PG8_SA(0, 0), cA, voffA); PG8_STAGE(PG8_SB(0, 1), cB + hstep, voffB); PG8_STAGE(PG8_SA(0, 1), cA + hstep, voffA);
        if (wr == 1) PG8_BAR;
        PG8_WAIT_V(4); PG8_BAR;
        PG8_STAGE(PG8_SB(1, 0), cB + kstep, voffB); PG8_STAGE(PG8_SA(1, 0), cA + kstep, voffA); PG8_STAGE(PG8_SB(1, 1), cB + hstep + kstep, voffB);
        PG8_WAIT_V(6); PG8_BAR;
    }
    for (;;) {
        const bool has_next = S.next(ui + 1, nxt);
        const char* nA = has_next ? (const char*)g.A + (size_t)nxt.pm * tstep : cA; const char* nB = has_next ? (const char*)g.Bt + (size_t)nxt.pn * tstep : cB;
        for (int t = 0; t < nt; t += 2) {
            const bool last = (t == nt - 2);
            const char* a1 = cA + (size_t)(t + 1) * kstep;
            const char* a2 = last ? nA : cA + (size_t)(t + 2) * kstep; const char* b2 = last ? nB : cB + (size_t)(t + 2) * kstep;
            const char* a3 = a2 + kstep; const char* b3 = b2 + kstep;
            if (last && has_next) S.a_ready(nxt);
            if constexpr (SP2) {
            PG8_LDB(B0, 0, 0); PG8_LDB(B1, 0, 1); PG8_SCHED; PG8_LDA(At, 0, 0); PG8_STAGE(PG8_SA(1, 1), a1 + hstep, voffA);
            PG8_WAIT_V(8); PG8_WAIT_L(0); PG8_BAR; PG8_MMA(0, 0, At, B0); PG8_MMA(0, 1, At, B1); PG8_BAR; PG8_SCHED;
            PG8_LDA(At, 0, 1); PG8_STAGE(PG8_SB(0, 0), b2, voffB); PG8_STAGE(PG8_SB(0, 1), b2 + hstep, voffB); PG8_STAGE(PG8_SA(0, 0), a2, voffA);
            PG8_WAIT_V(8); PG8_WAIT_L(0); PG8_BAR; PG8_MMA(1, 0, At, B0); PG8_MMA(1, 1, At, B1); PG8_BAR; PG8_SCHED;
            PG8_LDB(B0, 1, 0); PG8_LDB(B1, 1, 1); PG8_SCHED; PG8_LDA(At, 1, 0); PG8_STAGE(PG8_SA(0, 1), a2 + hstep, voffA);
            PG8_WAIT_V(8); PG8_WAIT_L(0); PG8_BAR; PG8_MMA(0, 0, At, B0); PG8_MMA(0, 1, At, B1); PG8_BAR; PG8_SCHED;
            PG8_LDA(At, 1, 1); PG8_STAGE(PG8_SB(1, 0), b3, voffB); PG8_STAGE(PG8_SB(1, 1), b3 + hstep, voffB); PG8_STAGE(PG8_SA(1, 0), a3, voffA);
            PG8_WAIT_V(8); PG8_WAIT_L(0); PG8_BAR; PG8_MMA(1, 0, At, B0); PG8_MMA(1, 1, At, B1); PG8_BAR; PG8_SCHED;
            } else {
            PG8_LDB(B0, 0, 0); PG8_SCHED; PG8_LDA(At, 0, 0); PG8_STAGE(PG8_SA(1, 1), a1 + hstep, voffA);
            PG8_WAIT_L(8); PG8_BAR; PG8_WAIT_L(0); PG8_MMA(0, 0, At, B0); PG8_BAR; PG8_SCHED;
            PG8_LDB(B1, 0, 1); PG8_STAGE(PG8_SB(0, 0), b2, voffB);
            PG8_BAR; PG8_WAIT_L(0); PG8_MMA(0, 1, At, B1); PG8_BAR;
            PG8_LDA(At, 0, 1); PG8_STAGE(PG8_SA(0, 0), a2, voffA);
            PG8_BAR; PG8_WAIT_L(0); PG8_MMA(1, 0, At, B0); PG8_BAR; PG8_SCHED;
            PG8_STAGE(PG8_SB(0, 1), b2 + hstep, voffB);
            PG8_WAIT_V(6); PG8_BAR; PG8_MMA(1, 1, At, B1); PG8_BAR;
            PG8_LDB(B0, 1, 0); PG8_SCHED; PG8_LDA(At, 1, 0); PG8_STAGE(PG8_SA(0, 1), a2 + hstep, voffA);
            PG8_WAIT_L(8); PG8_BAR; PG8_WAIT_L(0); PG8_MMA(0, 0, At, B0); PG8_BAR; PG8_SCHED;
            PG8_LDB(B1, 1, 1); PG8_STAGE(PG8_SB(1, 0), b3, voffB);
            PG8_BAR; PG8_WAIT_L(0); PG8_MMA(0, 1, At, B1); PG8_BAR;
            PG8_LDA(At, 1, 1); PG8_STAGE(PG8_SA(1, 0), a3, voffA);
            PG8_BAR; PG8_WAIT_L(0); PG8_MMA(1, 0, At, B0); PG8_BAR; PG8_SCHED;
            PG8_STAGE(PG8_SB(1, 1), b3 + hstep, voffB);
            PG8_WAIT_V(6); PG8_BAR; PG8_MMA(1, 1, At, B1); PG8_BAR;
            }
        }
        if constexpr (ALIGN_EPI) { if (wr == 0) PG8_BAR; }
        if constexpr (!Epi::AFTER_DRAIN) { E(acc, cur, wr, wc, fr, fq); S.done(cur); }
        if (!has_next) break;
#pragma unroll
        for (int a = 0; a < 2; ++a)
#pragma unroll
            for (int b = 0; b < 2; ++b)
#pragma unroll
                for (int m = 0; m < 4; ++m)
#pragma unroll
                    for (int n = 0; n < 2; ++n) acc[a][b][m][n] = (f32x4){0.f, 0.f, 0.f, 0.f};
        cur = nxt; cA = nA; cB = nB; ++ui;
        if constexpr (ALIGN_EPI) { if (wr == 1) PG8_BAR; }
    }
    PG8_WAIT_V(0);
    if constexpr (!ALIGN_EPI) { if (wr == 0) PG8_BAR; }
    PG8_BAR;
    if constexpr (Epi::AFTER_DRAIN) { E.fused(acc, cur, wr, wc, fr, fq, lds, wid, lane); S.done(cur); }
#undef PG8_SA
#undef PG8_SB
#undef PG8_STAGE
#undef PG8_LDA
#undef PG8_LDB
#undef PG8_MMA
#undef PG8_WAIT_V
#undef PG8_WAIT_L
#undef PG8_BAR
#undef PG8_SCHED
}
}
namespace att {
enum { ORDER_NATURAL = 0, ORDER_REVERSED = 1, ORDER_PAIRED = 2, ORDER_XCD = 4 };
constexpr int D = 128, PITCH = 2048;
constexpr float THR = 8.f;
constexpr bool WSKIP = false;
constexpr float SCALE = 0.08838834764831845f;
constexpr int NW = 8, QBLK = 32, KVBLK = 64, QB = NW * QBLK;
constexpr int SHM_V = KVBLK * D * 2, SHM_K = KVBLK * D * 2;
constexpr int LDS_BYTES = 2 * SHM_V + 2 * SHM_K + NW * 64 * 4;
using bf16 = __hip_bfloat16;
typedef short bf16x8 __attribute__((ext_vector_type(8)));
typedef short s16x4 __attribute__((ext_vector_type(4)));
typedef float f32x16 __attribute__((ext_vector_type(16)));
typedef float f32x4 __attribute__((ext_vector_type(4)));
typedef unsigned u32x4 __attribute__((ext_vector_type(4)));
template <class A, class Bt> struct same_t { static constexpr bool v = false; };
template <class A> struct same_t<A, A> { static constexpr bool v = true; };

#define KSWZ(row, colB) ((row) * 256 + ((colB) ^ (((row) & 7) << 4)))
#define SBAR() __builtin_amdgcn_sched_barrier(0)
__device__ __forceinline__ int v_st(int k, int c) { const int kk = (k & ~0xC) | ((k & 4) << 1) | ((k & 8) >> 1); return ((kk >> 3) * 4 + (c >> 5)) * 512 + ((kk & 7) * 32 + (c & 31)) * 2; }
__device__ __forceinline__ int v_rd_base(int lane) { return ((lane & 3) << 3) | (((lane >> 2) & 3) << 6) | (((lane >> 4) & 1) << 5) | (((lane >> 5) & 1) << 8); }
constexpr int v_rd_off(int d0, int ks, int half) { return d0 * 512 + ks * 4096 + half * 2048; }
__device__ __forceinline__ int crow(int r, int hi) { return (r & 3) + 8 * (r >> 2) + 4 * hi; }
__device__ __forceinline__ unsigned cvtpk(float lo, float hi) {
    unsigned r; asm volatile("v_cvt_pk_bf16_f32 %0, %1, %2" : "=v"(r) : "v"(lo), "v"(hi)); return r;
}
__device__ __forceinline__ bf16x8 pack8(f32x4 a, f32x4 b) {
    u32x4 w = {cvtpk(a[0], a[1]), cvtpk(a[2], a[3]), cvtpk(b[0], b[1]), cvtpk(b[2], b[3])};
    return *reinterpret_cast<bf16x8*>(&w);
}
template <class T> __device__ __forceinline__ bf16x8 load8(const T* p) {
    if constexpr (same_t<T, float>::v) { return pack8(*(const f32x4*)p, *(const f32x4*)(p + 4)); }
    else { return *reinterpret_cast<const bf16x8*>(p); }
}
__device__ __forceinline__ void mask_tile(f32x16& p0, f32x16& p1, int dq, unsigned W) {
    const float NEG = -__builtin_inff();
#pragma unroll
    for (int r = 0; r < 16; ++r) {
        const int c = (r & 3) + 8 * (r >> 2);
        if ((unsigned)(dq - c) >= W) p0[r] = NEG;
        if ((unsigned)(dq - c - 32) >= W) p1[r] = NEG;
    }
}
__device__ __forceinline__ void partialSM(f32x16& p0, f32x16& p1, float& m_reg, float& mn, float& alpha) {
    float pmax = p0[0]; for (int r = 1; r < 16; ++r) pmax = fmaxf(pmax, p0[r]); for (int r = 0; r < 16; ++r) pmax = fmaxf(pmax, p1[r]);
    { auto rr = __builtin_amdgcn_permlane32_swap(__float_as_uint(pmax), __float_as_uint(pmax), false, false);
      pmax = fmaxf(__uint_as_float(rr[0]), __uint_as_float(rr[1])); }
    constexpr float C2 = 1.4426950408889634f * SCALE;
    if (__builtin_expect(__all((pmax - m_reg) * SCALE <= THR), 1)) { mn = m_reg; alpha = 1.f; }
    else { mn = fmaxf(m_reg, pmax); alpha = __builtin_amdgcn_exp2f((m_reg - mn) * C2); m_reg = mn; }
    const float mnL = -mn * C2;
    for (int r = 0; r < 16; ++r) p0[r] = fmaf(p0[r], C2, mnL); for (int r = 0; r < 16; ++r) p1[r] = fmaf(p1[r], C2, mnL);
    for (int r = 0; r < 16; ++r) p0[r] = __builtin_amdgcn_exp2f(p0[r]);
}
__device__ __forceinline__ void finishSM(f32x16& p0, f32x16& p1, float alpha, float& l_reg, bf16x8& pa0, bf16x8& pa1, bf16x8& pa2, bf16x8& pa3) {
    for (int r = 0; r < 16; ++r) p1[r] = __builtin_amdgcn_exp2f(p1[r]);
    float ps = 0; for (int r = 0; r < 16; ++r) ps += p0[r]; for (int r = 0; r < 16; ++r) ps += p1[r];
    { auto rr = __builtin_amdgcn_permlane32_swap(__float_as_uint(ps), __float_as_uint(ps), false, false);
      ps = __uint_as_float(rr[0]) + __uint_as_float(rr[1]); }
    l_reg = l_reg * alpha + ps;
#define PK4(P, B_, OUT) do { unsigned a0 = cvtpk(P[B_+0], P[B_+1]), a1 = cvtpk(P[B_+2], P[B_+3]);                          \
        unsigned b0 = cvtpk(P[B_+4], P[B_+5]), b1 = cvtpk(P[B_+6], P[B_+7]);                                             \
        auto r0 = __builtin_amdgcn_permlane32_swap(a0, b0, false, false); auto r1 = __builtin_amdgcn_permlane32_swap(a1, b1, false, false); \
        u32x4 w = {r0[0], r1[0], r0[1], r1[1]}; OUT = *reinterpret_cast<bf16x8*>(&w); } while (0)
    PK4(p0, 0, pa0); PK4(p0, 8, pa1); PK4(p1, 0, pa2); PK4(p1, 8, pa3);
#undef PK4
}
template <int KB, bool SK>
__device__ __forceinline__ void qkt(f32x16& p0, f32x16& p1, const char* K_lds, int r32, int hi, const bf16x8* qr, bool act) {
    if (SK && !act) { const float NEG = -__builtin_inff();
#pragma unroll
        for (int r = 0; r < 16; ++r) { p0[r] = NEG; p1[r] = NEG; } return; }
    p0 = f32x16{}; p1 = f32x16{};
    const char* kb[4];
#pragma unroll
    for (int dd = 0; dd < 4; ++dd) kb[dd] = K_lds + KB * SHM_K + KSWZ(r32, (dd * 16 + hi * 8) * 2);
#pragma unroll
    for (int d0 = 0; d0 < 8; ++d0) { const char* a = kb[d0 & 3] + (d0 >> 2) * 128;
        bf16x8 b0 = *reinterpret_cast<const bf16x8*>(a);
        bf16x8 b1 = *reinterpret_cast<const bf16x8*>(a + 32 * 256);
        p0 = __builtin_amdgcn_mfma_f32_32x32x16_bf16(b0, qr[d0], p0, 0, 0, 0);
        p1 = __builtin_amdgcn_mfma_f32_32x32x16_bf16(b1, qr[d0], p1, 0, 0, 0); }
}
template <int VB, bool SK>
__device__ __forceinline__ void pv_tile(f32x16* o, int vb0, bf16x8 pa0, bf16x8 pa1, bf16x8 pa2, bf16x8 pa3, bool act) {
    if (SK && !act) return;
#define TRRD(dst, off) asm volatile("ds_read_b64_tr_b16 %0, %1 offset:%2" : "=&v"(dst) : "v"(vb0), "i"(off) : "memory")
#define PV_D0(d0) do { s16x4 l0, l1, l2, l3, h0, h1, h2, h3; constexpr int b_ = VB * SHM_V + v_rd_off(d0, 0, 0);     \
        TRRD(l0, b_); TRRD(h0, b_ + 2048); TRRD(l1, b_ + 4096); TRRD(h1, b_ + 6144); TRRD(l2, b_ + 8192); TRRD(h2, b_ + 10240); TRRD(l3, b_ + 12288); TRRD(h3, b_ + 14336); \
        asm volatile("s_waitcnt lgkmcnt(0)" ::: "memory"); SBAR();                 \
        o[d0] = __builtin_amdgcn_mfma_f32_32x32x16_bf16(pa0, (bf16x8){l0[0], l0[1], l0[2], l0[3], h0[0], h0[1], h0[2], h0[3]}, o[d0], 0, 0, 0);   \
        o[d0] = __builtin_amdgcn_mfma_f32_32x32x16_bf16(pa1, (bf16x8){l1[0], l1[1], l1[2], l1[3], h1[0], h1[1], h1[2], h1[3]}, o[d0], 0, 0, 0);   \
        o[d0] = __builtin_amdgcn_mfma_f32_32x32x16_bf16(pa2, (bf16x8){l2[0], l2[1], l2[2], l2[3], h2[0], h2[1], h2[2], h2[3]}, o[d0], 0, 0, 0);   \
        o[d0] = __builtin_amdgcn_mfma_f32_32x32x16_bf16(pa3, (bf16x8){l3[0], l3[1], l3[2], l3[3], h3[0], h3[1], h3[2], h3[3]}, o[d0], 0, 0, 0); } while (0)
    PV_D0(0); PV_D0(1); PV_D0(2); PV_D0(3);
#undef PV_D0
#undef TRRD
}

template <class TIn, class TOut> struct BlockRef { const TIn* Q; const TIn* K; const TIn* V; TOut* O; int P0; };
template <class TIn> struct Seam {
    bf16x8 qr[8];
    bf16x8 st_v0, st_v1, st_k0, st_k1; f32x4 sf0, sf1, sf2, sf3;
    f32x4 tq[16];
};
__device__ __forceinline__ int swa_jlo(int P0, int W) { const int lowk = P0 - W + 1; return lowk > 0 ? lowk / KVBLK : 0; }
#define ROW(p, k0, rr) ((p) + (size_t)((k0) + (rr)) * PITCH + sc)
#define VMW() asm volatile("s_waitcnt vmcnt(0)" ::: "memory")
#define VMWN(n) asm volatile("s_waitcnt vmcnt(%0)" :: "i"(n) : "memory")
#define SLOAD_H(Kp, Vp, k0) do { S.st_v0 = load8<TIn>(ROW(Vp, k0, sr)); S.st_v1 = load8<TIn>(ROW(Vp, k0, 32 + sr));              \
                         S.st_k0 = load8<TIn>(ROW(Kp, k0, sr)); S.st_k1 = load8<TIn>(ROW(Kp, k0, 32 + sr)); } while (0)
#define SWRITE_HK(bf) do { *(bf16x8*)(K_lds + (bf) * SHM_K + kws) = S.st_k0; *(bf16x8*)(K_lds + (bf) * SHM_K + kws + 32 * 256) = S.st_k1; } while (0)
#define SWRITE_HV(bf) do { *(bf16x8*)(V_lds + (bf) * SHM_V + vst0) = S.st_v0; *(bf16x8*)(V_lds + (bf) * SHM_V + vst1) = S.st_v1; } while (0)
#define SWRITE_H(bf) do { SWRITE_HV(bf); SWRITE_HK(bf); } while (0)
#define SLOAD_F(p, k0) do { S.sf0 = *(const f32x4*)ROW(p, k0, sr); S.sf1 = *(const f32x4*)(ROW(p, k0, sr) + 4);                \
                            S.sf2 = *(const f32x4*)ROW(p, k0, 32 + sr); S.sf3 = *(const f32x4*)(ROW(p, k0, 32 + sr) + 4); } while (0)
#define SWRITE_KF(bf) do { *(bf16x8*)(K_lds + (bf) * SHM_K + kws) = pack8(S.sf0, S.sf1); *(bf16x8*)(K_lds + (bf) * SHM_K + kws + 32 * 256) = pack8(S.sf2, S.sf3); } while (0)
#define SWRITE_VF(bf) do { *(bf16x8*)(V_lds + (bf) * SHM_V + vst0) = pack8(S.sf0, S.sf1); *(bf16x8*)(V_lds + (bf) * SHM_V + vst1) = pack8(S.sf2, S.sf3); } while (0)
template <class TIn, class TOut>
__device__ __forceinline__ void causal_swa_prime(const BlockRef<TIn, TOut>& cur, int W, char* lds, Seam<TIn>& S) {
    constexpr bool F32 = same_t<TIn, float>::v;
    const int tid = opaque_tid(), wid = __builtin_amdgcn_readfirstlane(tid >> 6), lane = tid & 63, r32 = lane & 31, hi = lane >> 5;
    const int sr = tid >> 4, sc = (tid & 15) * 8, kws = KSWZ(sr, sc * 2); char* K_lds = lds + 2 * SHM_V;
    const int kb0 = swa_jlo(cur.P0, W) * KVBLK;
    for (int d0 = 0; d0 < 8; ++d0) S.qr[d0] = load8<TIn>(cur.Q + (size_t)(wid * QBLK + r32) * PITCH + d0 * 16 + hi * 8);
    if constexpr (F32) { SLOAD_F((const float*)cur.K, kb0); VMW(); SWRITE_KF(0); SBAR(); SLOAD_F((const float*)cur.V, kb0); }
    else { SLOAD_H(cur.K, cur.V, kb0); VMW(); SWRITE_HK(0); }
    __syncthreads();
}
template <class TIn, class TOut>
__device__ __forceinline__ void causal_swa_block(const BlockRef<TIn, TOut>& cur, const BlockRef<TIn, TOut>& nxt, int skv, int W, char* lds, Seam<TIn>& S) {
    constexpr bool F32 = same_t<TIn, float>::v;
    const int tid = opaque_tid(), wid = __builtin_amdgcn_readfirstlane(tid >> 6), lane = tid & 63, r32 = lane & 31, hi = lane >> 5;
    const int j_lo = swa_jlo(cur.P0, W);
    int j_hi = (cur.P0 + QB - 1) / KVBLK + 1; if (j_hi > skv / KVBLK) j_hi = skv / KVBLK;
    const int NT = j_hi - j_lo;
    const int kbn = swa_jlo(nxt.P0, W) * KVBLK;
    const int qlo = cur.P0 + wid * QBLK, qm = qlo + r32 - 4 * hi;
    char* V_lds = lds; char* K_lds = lds + 2 * SHM_V;
    float* ws = (float*)(lds + 2 * SHM_V + 2 * SHM_K) + wid * 64; float* li_l = ws, * al_l = ws + 32;
    float m_reg = -1e30f, l_reg = 0; f32x16 o[4] = {};
    const int sr = tid >> 4, sc = (tid & 15) * 8, vst0 = v_st(sr, sc), vst1 = v_st(32 + sr, sc), kws = KSWZ(sr, sc * 2);
    const int vb0 = (int)(uintptr_t)V_lds + v_rd_base(lane);
    const TIn* Kh = cur.K; const TIn* Vh = cur.V;
#define RESC(a) do { if (__any((a) < 1.f)) { if (hi == 0) al_l[r32] = (a); asm volatile("s_waitcnt lgkmcnt(0)" ::: "memory");              \
                     for (int d_ = 0; d_ < 4; ++d_) for (int r = 0; r < 16; ++r) o[d_][r] *= al_l[crow(r, hi)]; } } while (0)
#define KBASE(t) ((j_lo + (t)) * KVBLK)
#define ACT(t) (KBASE(t) <= qlo + QBLK - 1 && KBASE(t) + KVBLK - 1 >= qlo - W + 1)
#define MASKT(P0_, P1_, t) do { const int kb_ = KBASE(t); if ((!SK || ACT(t)) && (kb_ + KVBLK - 1 > qlo || kb_ <= qlo + QBLK - 1 - W)) mask_tile(P0_, P1_, qm - kb_, (unsigned)W); } while (0)
    constexpr int NQL = F32 ? 16 : 8;
    constexpr bool SK = WSKIP && !F32;
#define SEAM_K0() do { VMWN(NQL); if constexpr (F32) { SWRITE_KF(0); SBAR(); SLOAD_F((const float*)nxt.V, kbn); } else { SWRITE_HK(0); } SBAR(); } while (0)
    f32x16 pA0, pA1, pB0, pB1; float mnA, mnB, alA, alB; bf16x8 pa0, pa1, pa2, pa3;
    if constexpr (F32) { VMW(); SWRITE_VF(0); SBAR(); } else { SWRITE_HV(0); SBAR(); }
    if (NT > 1) { if constexpr (F32) SLOAD_F((const float*)Kh, KBASE(1)); else SLOAD_H(Kh, Vh, KBASE(1)); }
    SBAR(); qkt<0, SK>(pA0, pA1, K_lds, r32, hi, S.qr, ACT(0));
    if constexpr (F32) { if (NT > 1) { VMW(); SWRITE_KF(1); SBAR(); SLOAD_F((const float*)Vh, KBASE(1)); } }
    MASKT(pA0, pA1, 0); partialSM(pA0, pA1, m_reg, mnA, alA);
    if (NT > 1) { VMW(); if constexpr (F32) { SWRITE_VF(1); SBAR(); if (NT > 2) SLOAD_F((const float*)Kh, KBASE(2)); } else SWRITE_H(1); }
    __syncthreads();
#define HALF_STEP(PX0, PX1, mnX, alX, PY0, PY1, alY, t, KB, VB, SB) do {                                                      \
        SBAR(); qkt<KB, SK>(PX0, PX1, K_lds, r32, hi, S.qr, ACT(t));                                             \
        finishSM(PY0, PY1, alY, l_reg, pa0, pa1, pa2, pa3); SBAR();                                                           \
        if ((t) + 1 < NT) { if constexpr (F32) { VMW(); SWRITE_KF(SB); SBAR(); SLOAD_F((const float*)Vh, KBASE((t) + 1)); }  \
                            else { SLOAD_H(Kh, Vh, KBASE((t) + 1)); } SBAR(); }                                               \
        pv_tile<VB, SK>(o, vb0, pa0, pa1, pa2, pa3, ACT((t) - 1)); MASKT(PX0, PX1, (t)); partialSM(PX0, PX1, m_reg, mnX, alX);                                        \
        __syncthreads();                                                                                                      \
        if ((t) + 1 < NT) { VMW(); if constexpr (F32) { SWRITE_VF(SB); SBAR(); if ((t) + 2 < NT) SLOAD_F((const float*)Kh, KBASE((t) + 2)); } \
                            else { SWRITE_H(SB); } }                                                                          \
        RESC(alX); __syncthreads(); } while (0)
    for (int t = 1; t + 1 < NT; t += 2) {
        HALF_STEP(pB0, pB1, mnB, alB, pA0, pA1, alA, t, 1, 0, 0);
        HALF_STEP(pA0, pA1, mnA, alA, pB0, pB1, alB, t + 1, 0, 1, 1);
    }
    const bool even = (NT & 1) == 0;
    if (even) { SBAR(); qkt<1, SK>(pB0, pB1, K_lds, r32, hi, S.qr, ACT(NT - 1)); SBAR(); }
#define QROW(e) (nxt.Q + (size_t)(wid * QBLK + r32) * PITCH + ((e) >> 1) * 16 + hi * 8 + ((e) & 1) * 4)
    if constexpr (F32) { SLOAD_F((const float*)nxt.K, kbn); SBAR();
#pragma unroll
        for (int e = 0; e < 8; ++e) S.tq[e] = *(const f32x4*)QROW(e); }
    else { SLOAD_H(nxt.K, nxt.V, kbn); SBAR();
#pragma unroll
        for (int d0 = 0; d0 < 8; ++d0) S.qr[d0] = load8<TIn>(nxt.Q + (size_t)(wid * QBLK + r32) * PITCH + d0 * 16 + hi * 8); }
    SBAR();
    finishSM(pA0, pA1, alA, l_reg, pa0, pa1, pa2, pa3); SBAR();
    if constexpr (F32) {
#pragma unroll
        for (int e = 8; e < 16; ++e) S.tq[e] = *(const f32x4*)QROW(e); SBAR(); }
#undef QROW
    pv_tile<0, SK>(o, vb0, pa0, pa1, pa2, pa3, ACT(even ? NT - 2 : NT - 1));
    if (even) { MASKT(pB0, pB1, NT - 1); partialSM(pB0, pB1, m_reg, mnB, alB); __syncthreads(); RESC(alB);
        finishSM(pB0, pB1, alB, l_reg, pa0, pa1, pa2, pa3); SBAR(); pv_tile<1, SK>(o, vb0, pa0, pa1, pa2, pa3, ACT(NT - 1)); }
    SBAR(); SEAM_K0();
    if (hi == 0) li_l[r32] = l_reg; asm volatile("s_waitcnt lgkmcnt(0)" ::: "memory");
    float rli[16];
#pragma unroll
    for (int r = 0; r < 16; ++r) rli[r] = __builtin_amdgcn_rcpf(li_l[crow(r, hi)]);
    TOut* Ow = cur.O + (size_t)(wid * QBLK) * PITCH;
#pragma unroll
    for (int r = 0; r < 16; ++r) { const int orow = crow(r, hi);
#pragma unroll
        for (int d0 = 0; d0 < 4; ++d0) { const float v = o[d0][r] * rli[r];
            if constexpr (same_t<TOut, float>::v) { Ow[(size_t)orow * PITCH + d0 * 32 + r32] = v; }
            else { const float vn = __shfl_xor(v, 1);
                   if ((r32 & 1) == 0) *(unsigned*)(Ow + (size_t)orow * PITCH + d0 * 32 + r32) = cvtpk(v, vn); } } }
    if constexpr (F32) {
#pragma unroll
        for (int d0 = 0; d0 < 8; ++d0) S.qr[d0] = pack8(S.tq[2 * d0], S.tq[2 * d0 + 1]); }
    __syncthreads();
#undef RESC
#undef KBASE
#undef ACT
#undef MASKT
#undef SEAM_K0
#undef HALF_STEP
}
#undef ROW
#undef VMW
#undef VMWN
#undef SLOAD_H
#undef SWRITE_HK
#undef SWRITE_HV
#undef SWRITE_H
#undef SLOAD_F
#undef SWRITE_KF
#undef SWRITE_VF

__host__ __device__ inline int swa_nx(int nqb, int nramp, int order) { return (order & ORDER_PAIRED) ? (nramp + 1) / 2 + (nqb - nramp) : nqb; }
struct SwaItem { int bh, qb0, qb1; };
__device__ __forceinline__ SwaItem swa_decode(int L, int nb, int nh, int nhkv, int nqb, int nx, int nramp, int order) {
    const int G = nh / nhkv; SwaItem it; int x;
    if ((order & ORDER_XCD) && (nb * nhkv) % 8 == 0) { const int xcd = L & 7, k = L >> 3, per = G * nx, gi = k / per, r = k - gi * per;
        it.bh = (gi * 8 + xcd) * G + r / nx; x = r % nx; }
    else { it.bh = L / nx; x = L - it.bh * nx; }
    if (order & ORDER_PAIRED) { const int ns = nqb - nramp;
        if (x < ns) { it.qb0 = it.qb1 = nqb - 1 - x; } else { it.qb0 = x - ns; it.qb1 = nramp - 1 - it.qb0; } }
    else { it.qb0 = it.qb1 = ((order & 3) == ORDER_REVERSED) ? nqb - 1 - x : x; }
    return it;
}
}
constexpr int NWAVES = 8;
constexpr int BATCH = 4, SEQ = 4096, DM = 4096, M = BATCH * SEQ;
constexpr int AW = 2048, INW = 12288, DFF = 11008, UPW = 22016, NMOD = 6 * DM;
constexpr float EPS = 1e-6f;
constexpr float LAM_INIT = 0.2f;
constexpr int ADA_KS = 64;
constexpr size_t MiB = 1u << 20;
constexpr size_t WS_CTL = 0, CTL_ZERO_BYTES = 1 * MiB;
constexpr size_t WS_VEC = 1 * MiB;
constexpr size_t WS_SS = 2 * MiB;
constexpr size_t WS_COS = 6 * MiB, WS_SIN = 10 * MiB;
constexpr size_t WS_ADAP = 14 * MiB;
constexpr size_t WS_EDGE = 38 * MiB;
constexpr size_t WS_WIN = 124 * MiB, WS_WOUT = 220 * MiB, WS_WUP = 252 * MiB, WS_WDN = 424 * MiB;
constexpr size_t WS_H = 510 * MiB;
constexpr size_t WS_Y = 638 * MiB;
constexpr size_t WS_PROJ = 894 * MiB;
constexpr size_t WS_O = 1278 * MiB;
constexpr size_t WS_G = 894 * MiB;
constexpr size_t WS_END = 1406 * MiB;
static_assert(WS_WIN + (size_t)INW * DM * 2 <= WS_WOUT && WS_WOUT + (size_t)DM * DM * 2 <= WS_WUP && WS_WUP + (size_t)UPW * DM * 2 <= WS_WDN && WS_WDN + (size_t)DM * DFF * 2 <= WS_H, "weights map");
static_assert(WS_EDGE + (size_t)256 * 4 * UPW * 4 <= WS_WIN && WS_ADAP + (size_t)ADA_KS * 4 * NMOD * 4 <= WS_EDGE && WS_H + (size_t)M * DM * 2 <= WS_Y && WS_Y + (size_t)M * DM * 4 <= WS_PROJ, "map");
static_assert(WS_PROJ + 6 * (size_t)M * AW * 2 <= WS_O && WS_O + 2 * (size_t)M * AW * 2 <= WS_END && WS_G + (size_t)M * DFF * 2 <= WS_END, "map 2");
constexpr int CW_TMO = 0, CW_CODE = 1, CW_BAR = 4096;
constexpr int RING_OFF = 0, RING_BYTES = 131072;
constexpr int LDSCTL_OFF = RING_BYTES, MISC_OFF = LDSCTL_OFF + 320;
constexpr int LDS_BYTES = 147456;
static_assert(MISC_OFF + 128 <= LDS_BYTES && att::LDS_BYTES <= RING_BYTES, "LDS map");

#define GAS __attribute__((address_space(1)))
#define LAS __attribute__((address_space(3)))
typedef unsigned short bf16;
typedef unsigned v4u __attribute__((ext_vector_type(4)));
typedef float f32x4 __attribute__((ext_vector_type(4)));
typedef short bf16x8 __attribute__((ext_vector_type(8)));
typedef GAS unsigned gu32;
typedef GAS unsigned long long gu64;
#define RLX_AGENT __ATOMIC_RELAXED, __HIP_MEMORY_SCOPE_AGENT
#define LDS_WAIT() asm volatile("s_waitcnt lgkmcnt(0)" ::: "memory")
#define VM_WAIT() asm volatile("s_waitcnt vmcnt(0)" ::: "memory")
__device__ __forceinline__ unsigned long long rt() { return __builtin_amdgcn_s_memrealtime(); }
__device__ __forceinline__ unsigned f2bf(float f) { unsigned u = __builtin_bit_cast(unsigned, f); return (u + 0x7fffu + ((u >> 16) & 1u)) >> 16; }
__device__ __forceinline__ unsigned pk2(float lo, float hi) { return f2bf(lo) | (f2bf(hi) << 16); }

#define XB_TMO      128
#define XB_XCNT(j)  (256  + 64 * (j))
#define XB_XSUB(j)  (1280 + 64 * (j))
#define XB_XGEN(j)  (2304 + 64 * (j))
#define XB_TOP      3328
#define XB_TOPGEN   3392
#define XCD_BAR_WORDS 3456
#define XB_SPIN_CAP (1u << 18)

__device__ __forceinline__ unsigned xb_ld(unsigned* p)              { return __hip_atomic_load(p, __ATOMIC_RELAXED, __HIP_MEMORY_SCOPE_AGENT); }
__device__ __forceinline__ unsigned xb_add(unsigned* p, unsigned v) { return __hip_atomic_fetch_add(p, v, __ATOMIC_RELAXED, __HIP_MEMORY_SCOPE_AGENT); }
__device__ __forceinline__ unsigned xb_xcc_id() { return (unsigned)__builtin_amdgcn_s_getreg((3 << 11) | 20) & 0xFu; }
#define XB_SPIN(cond, bar) do { unsigned _sp = 0; while (cond) { __builtin_amdgcn_s_sleep(1); \
    if ((++_sp & 255u) == 0u) { if (xb_ld(&(bar)[XB_TMO])) break; if (_sp > XB_SPIN_CAP) { atomicAdd(&(bar)[XB_TMO], 1u); break; } } } } while (0)

struct XcdBarrier {
    unsigned* bar; unsigned x;
    volatile LAS unsigned* st;
};

__device__ __forceinline__ XcdBarrier xcd_barrier_post(unsigned* bar, volatile LAS unsigned* st) {
    XcdBarrier b; b.bar = bar; b.x = xb_xcc_id(); b.st = st;
    if (threadIdx.x == 0) (void)xb_add(&bar[XB_XCNT(b.x)], 1u);
    return b;
}
__device__ __forceinline__ void xcd_barrier_complete(unsigned* bar, unsigned x, unsigned& nloc, unsigned& nx) {
    const unsigned G = gridDim.x * gridDim.y * gridDim.z;
    unsigned sum, cnt, mine, sp = 0u;
    for (;;) {
        sum = 0u; cnt = 0u; mine = 0u;
#pragma unroll
        for (unsigned j = 0; j < 16; ++j) { const unsigned c = xb_ld(&bar[XB_XCNT(j)]); sum += c; cnt += (c > 0u) ? 1u : 0u; mine = (j == x) ? c : mine; }
        if (sum == G) break;
        __builtin_amdgcn_s_sleep(1);
        if ((++sp & 255u) == 0u) { if (xb_ld(&bar[XB_TMO])) break; if (sp > XB_SPIN_CAP) { atomicAdd(&bar[XB_TMO], 1u); break; } }
    }
    nloc = mine > 0u ? mine : 1u; nx = cnt > 0u ? cnt : 1u;
}

__device__ __forceinline__ void xcd_barrier(const XcdBarrier& b) {
    asm volatile("s_waitcnt vmcnt(0)" ::: "memory");
    __syncthreads();
    if (threadIdx.x == 0) {
        unsigned* bar = b.bar;
        __builtin_amdgcn_s_waitcnt(0);
        unsigned nloc = b.st[0], nx = b.st[1];
        if (nloc == 0u) { xcd_barrier_complete(bar, b.x, nloc, nx); b.st[0] = nloc; b.st[1] = nx; }
        const unsigned old = xb_add(&bar[XB_XSUB(b.x)], 1u);
        const unsigned gen = old / nloc;
        if (old + 1u == (gen + 1u) * nloc) {
            __builtin_amdgcn_fence(__ATOMIC_RELEASE, "agent");
            asm volatile("s_waitcnt vmcnt(0)" ::: "memory");
            const unsigned og = xb_add(&bar[XB_TOP], 1u);
            const unsigned tg = og / nx;
            if (og + 1u == (tg + 1u) * nx) xb_add(&bar[XB_TOPGEN], 1u);
            else XB_SPIN(xb_ld(&bar[XB_TOPGEN]) == tg, bar);
            __builtin_amdgcn_fence(__ATOMIC_ACQUIRE, "agent");
            xb_add(&bar[XB_XGEN(b.x)], 1u);
            asm volatile("s_waitcnt vmcnt(0)" ::: "memory");
        } else {
            XB_SPIN(xb_ld(&bar[XB_XGEN(b.x)]) == gen, bar);
            __builtin_amdgcn_fence(__ATOMIC_ACQUIRE, "agent");
            asm volatile("s_waitcnt vmcnt(0)" ::: "memory");
        }
    }
    __syncthreads();
}
__device__ __forceinline__ float wave_sum(float v) {
#pragma unroll
    for (int o = 1; o < 64; o <<= 1) v += __shfl_xor(v, o);
    return v;
}
__device__ __forceinline__ float bflo(unsigned w) { return __builtin_bit_cast(float, w << 16); }
__device__ __forceinline__ float bfhi(unsigned w) { return __builtin_bit_cast(float, w & 0xffff0000u); }

template <int MODE> __device__ __forceinline__ int wrow_map(int n) {
    if (MODE == 1) { if (n >= 2 * AW) return n; const int d = n & 127; return (n & ~127) + 32 * ((d >> 4) & 3) + 8 * ((d >> 2) & 3) + 4 * (d >> 6) + (d & 3); }
    if (MODE == 2) { const int v = n >= DFF ? 1 : 0, f = n - v * DFF; return (f >> 7) * 256 + v * 128 + (f & 127); }
    return n;
}
template <int MODE> __device__ __forceinline__ void p0_transpose_item(const float* W, int K, int N, bf16* WT, LAS float* scr, int item, int lane) {
    const int nblk = N / 32, kb = item / nblk, nb = item % nblk, k0 = 64 * kb, n0 = 32 * nb;
#pragma unroll 8
    for (int i = 0; i < 32; ++i) { const int kk = 2 * i + (lane >> 5); scr[kk * 33 + (lane & 31)] = W[(size_t)(k0 + kk) * N + n0 + (lane & 31)]; }
    LDS_WAIT(); asm volatile("" ::: "memory");
    const int c = lane & 7;
#pragma unroll
    for (int j = 0; j < 4; ++j) { const int n = (lane >> 3) + 8 * j; const LAS float* s = scr + (8 * c) * 33 + n;
        v4u o; o.x = pk2(s[0 * 33], s[1 * 33]); o.y = pk2(s[2 * 33], s[3 * 33]); o.z = pk2(s[4 * 33], s[5 * 33]); o.w = pk2(s[6 * 33], s[7 * 33]);
        *(GAS v4u*)(WT + (size_t)wrow_map<MODE>(n0 + n) * K + k0 + 8 * c) = o; }
    LDS_WAIT(); asm volatile("" ::: "memory");
}

__device__ __forceinline__ void p0_ada_task(const float* cvec, const float* wada, float* part, int task, int lane) {
    const int ec = task % 96, ks = task / 96, e = ec * 256 + lane * 4, dbase = ks * 64;
    float sv[4];
#pragma unroll
    for (int b = 0; b < 4; ++b) { const float c = cvec[b * DM + dbase + lane]; sv[b] = c / (1.0f + __expf(-c)); }
    f32x4 acc[4];
#pragma unroll
    for (int b = 0; b < 4; ++b) acc[b] = (f32x4){0.f, 0.f, 0.f, 0.f};
    const float* wp = wada + (size_t)dbase * NMOD + e;
#pragma unroll 8
    for (int l = 0; l < 64; ++l) {
        const f32x4 w = *(const f32x4*)(wp + (size_t)l * NMOD);
#pragma unroll
        for (int b = 0; b < 4; ++b) { const float s = __builtin_bit_cast(float, __builtin_amdgcn_readlane(__builtin_bit_cast(int, sv[b]), l)); acc[b] = acc[b] + w * s; }
    }
#pragma unroll
    for (int b = 0; b < 4; ++b) *(f32x4*)(part + ((size_t)ks * 4 + b) * NMOD + e) = acc[b];
}

__device__ __forceinline__ void norm_mod_row(const float* xrow, const float* A, const float* SH, bf16* orow, int lane) {
    f32x4 v[8][2]; float s = 0.f;
#pragma unroll
    for (int j = 0; j < 8; ++j)
#pragma unroll
        for (int h = 0; h < 2; ++h) { v[j][h] = *(const f32x4*)(xrow + 512 * j + 8 * lane + 4 * h); s += (v[j][h][0] * v[j][h][0] + v[j][h][1] * v[j][h][1]) + (v[j][h][2] * v[j][h][2] + v[j][h][3] * v[j][h][3]); }
    const float rstd = 1.0f / sqrtf(wave_sum(s) * (1.0f / DM) + EPS);
#pragma unroll
    for (int j = 0; j < 8; ++j) { const int c = 512 * j + 8 * lane;
        const f32x4 a0 = *(const f32x4*)(A + c), a1 = *(const f32x4*)(A + c + 4), s0 = *(const f32x4*)(SH + c), s1 = *(const f32x4*)(SH + c + 4);
        const f32x4 o0 = v[j][0] * rstd * a0 + s0, o1 = v[j][1] * rstd * a1 + s1;
        v4u w; w.x = pk2(o0[0], o0[1]); w.y = pk2(o0[2], o0[3]); w.z = pk2(o1[0], o1[1]); w.w = pk2(o1[2], o1[3]);
        *(GAS v4u*)(orow + c) = w; }
}
struct Args {
    const float* x; const float* c; const int* pos; const float* w_ada; const float* b_ada; const float* g_pre_mix; const float* g_post_mix; const float* w_in;
    const float* lq1; const float* lk1; const float* lq2; const float* lk2; const float* g_subln; const float* w_conv_mix; const float* w_out;
    const float* g_pre_ffn; const float* g_post_ffn; const float* w_up; const float* w_conv_ffn; const float* w_down;
    float* out; unsigned char* ws;
};
#ifndef PH_LAST
#define PH_LAST 99
#endif
__global__ void __launch_bounds__(NWAVES * 64, 2) fwd_kernel(Args args) {
    extern __shared__ __attribute__((aligned(16))) unsigned char lds[];
    LAS unsigned char* const ldsb = (LAS unsigned char*)lds;
    volatile LAS unsigned* const MISC = (volatile LAS unsigned*)(ldsb + MISC_OFF);
    const int G = gridDim.x, bx = blockIdx.x, NGW = G * NWAVES, NGT = G * NWAVES * 64;
#define PHASE_IDS() const int tid = opaque_tid(), lane = tid & 63, wave = __builtin_amdgcn_readfirstlane(tid >> 6), gw = bx * NWAVES + wave, gt = bx * (NWAVES * 64) + tid; (void)lane; (void)gw; (void)gt
    unsigned char* const ws = args.ws;
    gu32* const ctl = (gu32*)(ws + WS_CTL);
    float* const VEC = (float*)(ws + WS_VEC);
    float* const SS = (float*)(ws + WS_SS);
    float* const COST = (float*)(ws + WS_COS); float* const SINT = (float*)(ws + WS_SIN);
    float* const ADAP = (float*)(ws + WS_ADAP);
    float* const EDGE = (float*)(ws + WS_EDGE);
    bf16* const WIN_T = (bf16*)(ws + WS_WIN); bf16* const WOUT_T = (bf16*)(ws + WS_WOUT); bf16* const WUP_T = (bf16*)(ws + WS_WUP); bf16* const WDN_T = (bf16*)(ws + WS_WDN);
    bf16* const HB = (bf16*)(ws + WS_H); float* const YB = (float*)(ws + WS_Y);
    bf16* const PROJ = (bf16*)(ws + WS_PROJ); bf16* const OB = (bf16*)(ws + WS_O); bf16* const GB = (bf16*)(ws + WS_G);
    constexpr size_t SEC = (size_t)M * AW;
    bf16* const Qb = PROJ; bf16* const Kb = PROJ + SEC; bf16* const Vb = PROJ + 2 * SEC; bf16* const Bb = PROJ + 3 * SEC; bf16* const Cb = PROJ + 4 * SEC; bf16* const Hcb = PROJ + 5 * SEC;

    for (int u = threadIdx.x; u < (LDS_BYTES - LDSCTL_OFF) / 4; u += NWAVES * 64) ((LAS unsigned*)(ldsb + LDSCTL_OFF))[u] = 0u;
    __syncthreads();
    XcdBarrier bar = xcd_barrier_post((unsigned*)(ctl + CW_BAR), MISC + 8);
#define GRID_BAR() xcd_barrier(bar)

    {
        PHASE_IDS();
        for (int t = gw; t < 96 * ADA_KS; t += NGW) p0_ada_task(args.c, args.w_ada, ADAP, t, lane);
        for (int i = gt; i < M * 64; i += NGT) { const int row = i >> 6, k = i & 63;
            const float inv = (float)pow(10000.0, -(double)k / 64.0); const float ang = (float)args.pos[row] * inv;
            COST[i] = (float)cos((double)ang); SINT[i] = (float)sin((double)ang); }
        LAS float* scr = (LAS float*)(ldsb + RING_OFF + wave * 16384);
        constexpr int I_IN = (DM / 64) * (INW / 32), I_OUT = (DM / 64) * (DM / 32), I_UP = (DM / 64) * (UPW / 32), I_DN = (DFF / 64) * (DM / 32);
        constexpr int NITEMS = I_IN + I_OUT + I_UP + I_DN;
        for (int it = gw; it < NITEMS; it += NGW) {
            int r = it;
            if (r < I_IN) { p0_transpose_item<1>(args.w_in, DM, INW, WIN_T, scr, r, lane); continue; } r -= I_IN;
            if (r < I_OUT) { p0_transpose_item<0>(args.w_out, DM, DM, WOUT_T, scr, r, lane); continue; } r -= I_OUT;
            if (r < I_UP) { p0_transpose_item<2>(args.w_up, DM, UPW, WUP_T, scr, r, lane); continue; } r -= I_UP;
            p0_transpose_item<0>(args.w_down, DFF, DM, WDN_T, scr, r, lane);
        }
    }
    GRID_BAR();
    { PHASE_IDS();
    for (int i = gt; i < 4 * NMOD; i += NGT) { const int b = i / NMOD, e = i - b * NMOD;
        float s = 0.f;
        for (int ks = 0; ks < ADA_KS; ++ks) s += ADAP[((size_t)ks * 4 + b) * NMOD + e];
        s += args.b_ada[e];
        const int ch = e >> 12, col = e & 4095; float o;
        if (ch == 0 || ch == 3) o = s;
        else if (ch == 1) o = args.g_pre_mix[col] * (1.0f + s);
        else if (ch == 2) o = s * args.g_post_mix[col];
        else if (ch == 4) o = args.g_pre_ffn[col] * (1.0f + s);
        else o = s * args.g_post_ffn[col];
        VEC[((size_t)ch * 4 + b) * DM + col] = o; } }
    GRID_BAR();
    { PHASE_IDS();
    for (int m = gw; m < M; m += NGW) { const int b = m / SEQ;
        norm_mod_row(args.x + (size_t)m * DM, VEC + (size_t)(1 * 4 + b) * DM, VEC + (size_t)(0 * 4 + b) * DM, HB + (size_t)m * DM, lane); } }
    GRID_BAR();
    {
        pg8::Gemm g{HB, WIN_T, M, INW, DM}; pg8::StaticOrder S; S.init(M, INW, G, bx);
        pg8::EpiProj E{PROJ, COST, SINT};
        pg8::gemm_phase<pg8::EpiProj, pg8::StaticOrder, true, true>(ldsb + RING_OFF, g, S, E);
    }
    GRID_BAR();
    {
        using namespace att;
        constexpr int nb = 1, nh = 128, nhkv = 32, nqb = SEQ / QB, nramp = nqb, order = ORDER_PAIRED | ORDER_XCD;
        constexpr int nx = (nramp + 1) / 2, total = nx * nb * nh;
        const int stride = G;
        int L = bx;
        if (L < total) {
#define ATT_REF(r, it_, pass_) do { const int qb_ = (pass_) ? (it_).qb1 : (it_).qb0; const int kvg_ = (it_).bh >> 2, cmb_ = (it_).bh & 3, c_ = cmb_ >> 1, vh_ = cmb_ & 1, b_ = kvg_ >> 3, h_ = kvg_ & 7; \
            (r).Q = (const att::bf16*)Qb + ((size_t)b_ * SEQ + (size_t)qb_ * QB) * PITCH + h_ * 256 + c_ * 128; \
            (r).K = (const att::bf16*)Kb + ((size_t)b_ * SEQ) * PITCH + h_ * 256 + c_ * 128; \
            (r).V = (const att::bf16*)Vb + ((size_t)b_ * SEQ) * PITCH + h_ * 256 + vh_ * 128; \
            (r).O = (att::bf16*)OB + (size_t)c_ * SEC + ((size_t)b_ * SEQ + (size_t)qb_ * QB) * PITCH + h_ * 256 + vh_ * 128; (r).P0 = qb_ * QB; } while (0)
            SwaItem it = swa_decode(L, nb, nh, nhkv, nqb, nx, nramp, order); int pass = 0;
            BlockRef<att::bf16, att::bf16> cur; ATT_REF(cur, it, 0);
            Seam<att::bf16> S;
            causal_swa_prime<att::bf16, att::bf16>(cur, SEQ, (char*)lds + RING_OFF, S);
            for (;;) {
                const bool more_pass = pass == 0 && it.qb1 != it.qb0, more_item = L + stride < total, last = !more_pass && !more_item;
                SwaItem itn = it; int passn = pass + 1, Ln = L;
                if (!more_pass) { passn = 0; Ln = more_item ? L + stride : L; itn = swa_decode(Ln, nb, nh, nhkv, nqb, nx, nramp, order); }
                BlockRef<att::bf16, att::bf16> nxt = cur; if (!last) ATT_REF(nxt, itn, passn);
                causal_swa_block<att::bf16, att::bf16>(cur, nxt, SEQ, SEQ, (char*)lds + RING_OFF, S);
                if (last) break;
                cur = nxt; it = itn; pass = passn; L = Ln;
            }
#undef ATT_REF
        }
    }
    GRID_BAR();
    {
        PHASE_IDS();
        const float s1 = wave_sum(args.lq1[lane] * args.lk1[lane] + args.lq1[lane + 64] * args.lk1[lane + 64]);
        const float s2 = wave_sum(args.lq2[lane] * args.lk2[lane] + args.lq2[lane + 64] * args.lk2[lane + 64]);
        const float lam = expf(s1) - expf(s2) + LAM_INIT;
        const f32x4 gs0 = *(const f32x4*)(args.g_subln + (lane & 31) * 8), gs1 = *(const f32x4*)(args.g_subln + (lane & 31) * 8 + 4);
        const bf16* O1 = OB; const bf16* O2 = OB + SEC;
        for (int task = gw; task < M / 8; task += NGW) {
            const int r0 = task * 8;
            for (int rr = 0; rr < 8; ++rr) { const size_t rowoff = (size_t)(r0 + rr) * AW;
#pragma unroll
                for (int i = 0; i < 4; ++i) { const int col = i * 512 + lane * 8;
                    const v4u a = *(const GAS v4u*)(O1 + rowoff + col), b2 = *(const GAS v4u*)(O2 + rowoff + col);
                    float o[8];
                    o[0] = bflo(a.x) - lam * bflo(b2.x); o[1] = bfhi(a.x) - lam * bfhi(b2.x); o[2] = bflo(a.y) - lam * bflo(b2.y); o[3] = bfhi(a.y) - lam * bfhi(b2.y);
                    o[4] = bflo(a.z) - lam * bflo(b2.z); o[5] = bfhi(a.z) - lam * bfhi(b2.z); o[6] = bflo(a.w) - lam * bflo(b2.w); o[7] = bfhi(a.w) - lam * bfhi(b2.w);
                    float q = 0.f;
#pragma unroll
                    for (int j = 0; j < 8; ++j) q += o[j] * o[j];
#pragma unroll
                    for (int sft = 1; sft < 32; sft <<= 1) q += __shfl_xor(q, sft);
                    const float r = (1.0f / sqrtf(q * (1.0f / 256.0f) + EPS)) * (1.0f - LAM_INIT);
                    v4u w; w.x = pk2(o[0] * r * gs0[0], o[1] * r * gs0[1]); w.y = pk2(o[2] * r * gs0[2], o[3] * r * gs0[3]); w.z = pk2(o[4] * r * gs1[0], o[5] * r * gs1[1]); w.w = pk2(o[6] * r * gs1[2], o[7] * r * gs1[3]);
                    *(GAS v4u*)(HB + (size_t)(r0 + rr) * DM + col) = w; } }
            const bool has_prev = (r0 % SEQ) != 0;
#pragma unroll
            for (int i = 0; i < 4; ++i) { const int col = i * 512 + lane * 8;
                float w0[8], w1[8], w2[8];
#pragma unroll
                for (int j = 0; j < 8; ++j) { w0[j] = args.w_conv_mix[col + j]; w1[j] = args.w_conv_mix[AW + col + j]; w2[j] = args.w_conv_mix[2 * AW + col + j]; }
                float p2[8], p1[8];
#pragma unroll
                for (int j = 0; j < 8; ++j) { p2[j] = 0.f; p1[j] = 0.f; }
                if (has_prev) {
                    const v4u c2 = *(const GAS v4u*)(Cb + (size_t)(r0 - 2) * AW + col), h2 = *(const GAS v4u*)(Hcb + (size_t)(r0 - 2) * AW + col);
                    const v4u c1 = *(const GAS v4u*)(Cb + (size_t)(r0 - 1) * AW + col), h1 = *(const GAS v4u*)(Hcb + (size_t)(r0 - 1) * AW + col);
                    p2[0] = bflo(c2.x) * bflo(h2.x); p2[1] = bfhi(c2.x) * bfhi(h2.x); p2[2] = bflo(c2.y) * bflo(h2.y); p2[3] = bfhi(c2.y) * bfhi(h2.y);
                    p2[4] = bflo(c2.z) * bflo(h2.z); p2[5] = bfhi(c2.z) * bfhi(h2.z); p2[6] = bflo(c2.w) * bflo(h2.w); p2[7] = bfhi(c2.w) * bfhi(h2.w);
                    p1[0] = bflo(c1.x) * bflo(h1.x); p1[1] = bfhi(c1.x) * bfhi(h1.x); p1[2] = bflo(c1.y) * bflo(h1.y); p1[3] = bfhi(c1.y) * bfhi(h1.y);
                    p1[4] = bflo(c1.z) * bflo(h1.z); p1[5] = bfhi(c1.z) * bfhi(h1.z); p1[6] = bflo(c1.w) * bflo(h1.w); p1[7] = bfhi(c1.w) * bfhi(h1.w);
                }
                for (int rr = 0; rr < 8; ++rr) { const size_t ro = (size_t)(r0 + rr) * AW + col;
                    const v4u cc = *(const GAS v4u*)(Cb + ro), hh = *(const GAS v4u*)(Hcb + ro), bb = *(const GAS v4u*)(Bb + ro);
                    float p0[8], gb[8], o[8];
                    p0[0] = bflo(cc.x) * bflo(hh.x); p0[1] = bfhi(cc.x) * bfhi(hh.x); p0[2] = bflo(cc.y) * bflo(hh.y); p0[3] = bfhi(cc.y) * bfhi(hh.y);
                    p0[4] = bflo(cc.z) * bflo(hh.z); p0[5] = bfhi(cc.z) * bfhi(hh.z); p0[6] = bflo(cc.w) * bflo(hh.w); p0[7] = bfhi(cc.w) * bfhi(hh.w);
                    gb[0] = bflo(bb.x); gb[1] = bfhi(bb.x); gb[2] = bflo(bb.y); gb[3] = bfhi(bb.y); gb[4] = bflo(bb.z); gb[5] = bfhi(bb.z); gb[6] = bflo(bb.w); gb[7] = bfhi(bb.w);
#pragma unroll
                    for (int j = 0; j < 8; ++j) { o[j] = gb[j] * (w0[j] * p2[j] + w1[j] * p1[j] + w2[j] * p0[j]); p2[j] = p1[j]; p1[j] = p0[j]; }
                    v4u w; w.x = pk2(o[0], o[1]); w.y = pk2(o[2], o[3]); w.z = pk2(o[4], o[5]); w.w = pk2(o[6], o[7]);
                    *(GAS v4u*)(HB + (size_t)(r0 + rr) * DM + AW + col) = w; }
            }
        }
    }
    GRID_BAR();
    {
        pg8::Gemm g{HB, WOUT_T, M, DM, DM}; pg8::StaticOrder S; S.init(M, DM, G, bx);
        pg8::EpiF32SS E{YB, DM, SS};
        pg8::gemm_phase<pg8::EpiF32SS, pg8::StaticOrder, true, true>(ldsb + RING_OFF, g, S, E);
    }
    GRID_BAR();
    { PHASE_IDS();
    for (int m = gw; m < M; m += NGW) { const int b = m / SEQ;
        const float ssy = wave_sum(SS[(size_t)m * 64 + lane]);
        const float rsy = 1.0f / sqrtf(ssy * (1.0f / DM) + EPS);
        const float* xr = args.x + (size_t)m * DM; const float* yr = YB + (size_t)m * DM; float* o1 = args.out + (size_t)m * DM;
        const float* G1 = VEC + (size_t)(2 * 4 + b) * DM; const float* A2 = VEC + (size_t)(4 * 4 + b) * DM; const float* SH2 = VEC + (size_t)(3 * 4 + b) * DM;
        f32x4 v[8][2]; float s = 0.f;
#pragma unroll
        for (int j = 0; j < 8; ++j)
#pragma unroll
            for (int h = 0; h < 2; ++h) { const int c = 512 * j + 8 * lane + 4 * h;
                const f32x4 xv = *(const f32x4*)(xr + c), yv = *(const f32x4*)(yr + c), gv = *(const f32x4*)(G1 + c);
                const f32x4 x1 = xv + gv * yv * rsy; v[j][h] = x1; *(f32x4*)(o1 + c) = x1;
                s += (x1[0] * x1[0] + x1[1] * x1[1]) + (x1[2] * x1[2] + x1[3] * x1[3]); }
        const float rstd = 1.0f / sqrtf(wave_sum(s) * (1.0f / DM) + EPS);
        bf16* orow = HB + (size_t)m * DM;
#pragma unroll
        for (int j = 0; j < 8; ++j) { const int c = 512 * j + 8 * lane;
            const f32x4 a0 = *(const f32x4*)(A2 + c), a1 = *(const f32x4*)(A2 + c + 4), s0 = *(const f32x4*)(SH2 + c), s1 = *(const f32x4*)(SH2 + c + 4);
            const f32x4 q0 = v[j][0] * rstd * a0 + s0, q1 = v[j][1] * rstd * a1 + s1;
            v4u w; w.x = pk2(q0[0], q0[1]); w.y = pk2(q0[2], q0[3]); w.z = pk2(q1[0], q1[1]); w.w = pk2(q1[2], q1[3]);
            *(GAS v4u*)(orow + c) = w; }
    } }
    GRID_BAR();
    {
        pg8::Gemm g{HB, WUP_T, M, UPW, DM}; pg8::StaticOrder S; S.init(M, UPW, G, bx);
        pg8::EpiUp E{GB, args.w_conv_ffn, EDGE};
        pg8::gemm_phase<pg8::EpiUp, pg8::StaticOrder, true, true>(ldsb + RING_OFF, g, S, E);
    }
    GRID_BAR();
    { PHASE_IDS();
    for (int i = gt; i < 256 * (DFF / 4); i += NGT) { const int kb = i / (DFF / 4), f = (i - kb * (DFF / 4)) * 4;
        const int cg = (f >> 7) * 256 + (f & 127);
        const bool hp = (kb & 63) != 0;
        const float* e = EDGE + (size_t)kb * 4 * UPW;
        const f32x4 z = (f32x4){0.f, 0.f, 0.f, 0.f};
        const f32x4 g0 = hp ? *(const f32x4*)(e + cg) : z, g1 = hp ? *(const f32x4*)(e + UPW + cg) : z, g2 = *(const f32x4*)(e + 2 * UPW + cg), g3 = *(const f32x4*)(e + 3 * UPW + cg);
        const f32x4 v0 = hp ? *(const f32x4*)(e + cg + 128) : z, v1 = hp ? *(const f32x4*)(e + UPW + cg + 128) : z, v2 = *(const f32x4*)(e + 2 * UPW + cg + 128), v3 = *(const f32x4*)(e + 3 * UPW + cg + 128);
        const float* wc = args.w_conv_ffn;
        const f32x4 wg0 = *(const f32x4*)(wc + f), wg1 = *(const f32x4*)(wc + UPW + f), wg2 = *(const f32x4*)(wc + 2 * UPW + f);
        const f32x4 wv0 = *(const f32x4*)(wc + DFF + f), wv1 = *(const f32x4*)(wc + UPW + DFF + f), wv2 = *(const f32x4*)(wc + 2 * UPW + DFF + f);
        const f32x4 cga = wg0 * g0 + wg1 * g1 + wg2 * g2, cva = wv0 * v0 + wv1 * v1 + wv2 * v2;
        const f32x4 cgb = wg0 * g1 + wg1 * g2 + wg2 * g3, cvb = wv0 * v1 + wv1 * v2 + wv2 * v3;
        float oa[4], ob[4];
#pragma unroll
        for (int j = 0; j < 4; ++j) { oa[j] = pg8::silu_f(cga[j]) * cva[j]; ob[j] = pg8::silu_f(cgb[j]) * cvb[j]; }
        bf16* ga = GB + (size_t)(kb * 64) * DFF + f;
        *(GAS unsigned long long*)ga = (unsigned long long)pk2(oa[0], oa[1]) | ((unsigned long long)pk2(oa[2], oa[3]) << 32);
        *(GAS unsigned long long*)(ga + DFF) = (unsigned long long)pk2(ob[0], ob[1]) | ((unsigned long long)pk2(ob[2], ob[3]) << 32); } }
    GRID_BAR();
    {
        pg8::Gemm g{GB, WDN_T, M, DM, DFF}; pg8::StaticOrder S; S.init(M, DM, G, bx);
        pg8::EpiF32SS E{YB, DM, SS};
        pg8::gemm_phase<pg8::EpiF32SS, pg8::StaticOrder, true, true>(ldsb + RING_OFF, g, S, E);
    }
    GRID_BAR();
    { PHASE_IDS();
    for (int m = gw; m < M; m += NGW) { const int b = m / SEQ;
        const float ssf = wave_sum(SS[(size_t)m * 64 + lane]);
        const float rsf = 1.0f / sqrtf(ssf * (1.0f / DM) + EPS);
        const float* fr_ = YB + (size_t)m * DM; float* o1 = args.out + (size_t)m * DM; const float* G2 = VEC + (size_t)(5 * 4 + b) * DM;
#pragma unroll
        for (int j = 0; j < 8; ++j)
#pragma unroll
            for (int h = 0; h < 2; ++h) { const int c = 512 * j + 8 * lane + 4 * h;
                const f32x4 xv = *(const f32x4*)(o1 + c), fv = *(const f32x4*)(fr_ + c), gv = *(const f32x4*)(G2 + c);
                *(f32x4*)(o1 + c) = xv + gv * fv * rsf; }
    } }
}

extern "C" void kernel_launch(void* const* d_in, const int* in_sizes, int n_in, void* d_out, int out_size, void* d_ws, size_t ws_size, hipStream_t stream) {
    static int grid = 0;
    if (grid == 0) {
        if (n_in != 20 || in_sizes[0] != M * DM || out_size != M * DM || ws_size < WS_END) { fprintf(stderr, "kernel_launch: shape/workspace mismatch: n_in %d in0 %d out %d ws %zu (need %zu); nothing launched\n", n_in, n_in > 0 ? in_sizes[0] : -1, out_size, ws_size, (size_t)WS_END); grid = -1; return; }
        int dev = 0, cus = 0, per_cu = 0;
        if (hipGetDevice(&dev) != hipSuccess || hipDeviceGetAttribute(&cus, hipDeviceAttributeMultiprocessorCount, dev) != hipSuccess) { fprintf(stderr, "kernel_launch: device query failed\n"); grid = -1; return; }
        if (hipFuncSetAttribute((const void*)fwd_kernel, hipFuncAttributeMaxDynamicSharedMemorySize, LDS_BYTES) != hipSuccess) { fprintf(stderr, "kernel_launch: hipFuncSetAttribute failed\n"); grid = -1; return; }
        if (hipOccupancyMaxActiveBlocksPerMultiprocessor(&per_cu, (const void*)fwd_kernel, NWAVES * 64, LDS_BYTES) != hipSuccess || per_cu < 1)
            fprintf(stderr, "kernel_launch: note: occupancy query reports %d workgroups per CU\n", per_cu);
        (void)hipGetLastError();
        grid = cus;
    }
    if (grid < 0) return;
    if (hipMemsetAsync((char*)d_ws + WS_CTL, 0, CTL_ZERO_BYTES, stream) != hipSuccess) { fprintf(stderr, "kernel_launch: memset failed\n"); return; }
    Args a{};
    a.x = (const float*)d_in[0]; a.c = (const float*)d_in[1]; a.pos = (const int*)d_in[2]; a.w_ada = (const float*)d_in[3]; a.b_ada = (const float*)d_in[4];
    a.g_pre_mix = (const float*)d_in[5]; a.g_post_mix = (const float*)d_in[6]; a.w_in = (const float*)d_in[7];
    a.lq1 = (const float*)d_in[8]; a.lk1 = (const float*)d_in[9]; a.lq2 = (const float*)d_in[10]; a.lk2 = (const float*)d_in[11];
    a.g_subln = (const float*)d_in[12]; a.w_conv_mix = (const float*)d_in[13]; a.w_out = (const float*)d_in[14];
    a.g_pre_ffn = (const float*)d_in[15]; a.g_post_ffn = (const float*)d_in[16]; a.w_up = (const float*)d_in[17]; a.w_conv_ffn = (const float*)d_in[18]; a.w_down = (const float*)d_in[19];
    a.out = (float*)d_out; a.ws = (unsigned char*)d_ws;
    hipLaunchKernelGGL(fwd_kernel, dim3(grid), dim3(NWAVES * 64), LDS_BYTES, stream, a);
    const hipError_t le = hipPeekAtLastError();
    if (le != hipSuccess) fprintf(stderr, "kernel_launch: launch failed: %s\n", hipGetErrorName(le));
}
```

```cpp
#include <hip/hip_runtime.h>
#include <hip/hip_bf16.h>
#include <cstdio>
#include <cstdint>
__device__ __forceinline__ int opaque_tid() { int t; asm volatile("v_mov_b32 %0, %1" : "=v"(t) : "v"(threadIdx.x)); return t; }
namespace pg8 {
#define PG8_LAS __attribute__((address_space(3)))
typedef unsigned short bf16_t;
typedef short bf16x8 __attribute__((ext_vector_type(8)));
typedef float f32x4 __attribute__((ext_vector_type(4)));
typedef unsigned u32x4 __attribute__((ext_vector_type(4)));
constexpr int BM = 256, BK = 64, HALF = 128, HTB = HALF * BK * 2  , STAGE_BYTES = 8 * HTB, NXCD = 8, WGM = 8;

__host__ __device__ __forceinline__ int lds_byte(int r, int c) { const int st = (r >> 4) * 2 + (c >> 5), rr = r & 15, cc = c & 31, ob = rr * 64 + cc * 2; return st * 1024 + (ob ^ (((ob >> 9) & 1) << 5)); }
__host__ __device__ __forceinline__ void stage_rc(int b, int& R, int& C) { const int st = b / 1024, sb = b % 1024, swz = sb ^ (((sb >> 9) & 1) << 5); R = (st >> 1) * 16 + swz / 64; C = (st & 1) * 32 + (swz % 64) / 2; }
__host__ __device__ __forceinline__ int perm32(int rho) { const int n = rho >> 4, i = rho & 15; return 8 * (i >> 2) + 4 * n + (i & 3); }

struct Unit { int pm, pn; };
struct Gemm { const bf16_t* A; const bf16_t* Bt; int M, N, K; };

struct StaticOrder {
    int nM, nN, nwg, G, c, wgm;
    __host__ __device__ void init(int M, int N, int G_, int c_, int wgm_ = WGM) { nM = M / BM; nN = N / BM; nwg = nM * nN; G = G_; c = c_; wgm = wgm_; }
    __host__ __device__ bool next(int i, Unit& u) const {
        const long L = (long)i * G + c; if (L >= nwg) return false;
        int wgid = (int)L; { const int q = nwg / NXCD, r = nwg % NXCD, xcd = wgid % NXCD, off = wgid / NXCD; wgid = (xcd < r ? xcd * (q + 1) : r * (q + 1) + (xcd - r) * q) + off; }
        const int nig = wgm * nN, gid = wgid / nig, fm = gid * wgm, gsz = (nM - fm) < wgm ? (nM - fm) : wgm;
        u.pm = fm + ((wgid % nig) % gsz); u.pn = (wgid % nig) / gsz; return true;
    }
    __device__ __forceinline__ void a_ready(const Unit&) const {}
    __device__ __forceinline__ void done(const Unit&) const {}
};

__device__ __forceinline__ unsigned cvt_pk_bf16(float lo, float hi) { unsigned r; asm volatile("v_cvt_pk_bf16_f32 %0, %1, %2" : "=v"(r) : "v"(lo), "v"(hi)); return r; }
typedef float f32x2 __attribute__((ext_vector_type(2)));
constexpr int EP_M = 16384, EP_SECW = 2048, EP_DFF = 11008, EP_UPW = 22016;
constexpr size_t EP_SEC = (size_t)EP_M * EP_SECW;
__device__ __forceinline__ u32x4 pack8(const f32x4 a, const f32x4 b) { u32x4 w; w.x = cvt_pk_bf16(a[0], a[1]); w.y = cvt_pk_bf16(a[2], a[3]); w.z = cvt_pk_bf16(b[0], b[1]); w.w = cvt_pk_bf16(b[2], b[3]); return w; }

struct EpiProj {
    static constexpr bool PERM = true, AFTER_DRAIN = false, AROWS4 = false;
    bf16_t* out; const float* cosT; const float* sinT;
    __device__ __forceinline__ void operator()(const f32x4 (&acc)[2][2][4][2], const Unit& u, int wr, int wc, int fr, int fq) const {
        const int t = u.pn >> 3;
        bf16_t* base = out + (size_t)t * EP_SEC;
        const int row0 = u.pm * BM + wr * 64 + fr, col0 = (u.pn & 7) * BM + wc * 32 + 8 * fq;
        if (t < 2) {
            const int d0 = 16 * wc + 4 * fq;
#pragma unroll
            for (int ai = 0; ai < 2; ++ai)
#pragma unroll
                for (int m = 0; m < 4; ++m) { const int row = row0 + ai * HALF + m * 16;
                    const f32x4 cs = *(const f32x4*)(cosT + (size_t)row * 64 + d0), sn = *(const f32x4*)(sinT + (size_t)row * 64 + d0);
#pragma unroll
                    for (int bj = 0; bj < 2; ++bj) { const f32x4 t0 = acc[ai][bj][m][0], t1 = acc[ai][bj][m][1];
                        const f32x4 lo = t0 * cs - t1 * sn, hi = t1 * cs + t0 * sn;
                        *(u32x4*)(base + (size_t)row * EP_SECW + col0 + bj * HALF) = pack8(lo, hi); } }
        } else {
#pragma unroll
            for (int ai = 0; ai < 2; ++ai)
#pragma unroll
                for (int m = 0; m < 4; ++m) { const int row = row0 + ai * HALF + m * 16;
#pragma unroll
                    for (int bj = 0; bj < 2; ++bj) *(u32x4*)(base + (size_t)row * EP_SECW + col0 + bj * HALF) = pack8(acc[ai][bj][m][0], acc[ai][bj][m][1]); }
        }
    }
};

struct EpiF32SS {
    static constexpr bool PERM = false, AFTER_DRAIN = false, AROWS4 = false;
    float* C; int ldc; float* ss;
    __device__ __forceinline__ void operator()(const f32x4 (&acc)[2][2][4][2], const Unit& u, int wr, int wc, int fr, int fq) const {
        const int row0 = u.pm * BM + wr * 64 + fr, col0 = u.pn * BM + wc * 32 + 4 * fq;
#pragma unroll
        for (int ai = 0; ai < 2; ++ai)
#pragma unroll
            for (int m = 0; m < 4; ++m) { const int row = row0 + ai * HALF + m * 16; float* rowp = C + (size_t)row * ldc + col0; float s = 0.f;
#pragma unroll
                for (int bj = 0; bj < 2; ++bj)
#pragma unroll
                    for (int n = 0; n < 2; ++n) { const f32x4 v = acc[ai][bj][m][n]; *(f32x4*)(rowp + bj * HALF + n * 16) = v; s += (v[0] * v[0] + v[1] * v[1]) + (v[2] * v[2] + v[3] * v[3]); }
                s += __shfl_xor(s, 16); s += __shfl_xor(s, 32);
                if (fq == 0) ss[(size_t)row * 64 + u.pn * 4 + wc] = s; }
    }
};

struct EpiBf16SS {
    static constexpr bool PERM = true, AFTER_DRAIN = false, AROWS4 = false;
    bf16_t* C; int ldc; float* ss;
    __device__ __forceinline__ void operator()(const f32x4 (&acc)[2][2][4][2], const Unit& u, int wr, int wc, int fr, int fq) const {
        const int row0 = u.pm * BM + wr * 64 + fr, col0 = u.pn * BM + wc * 32 + 8 * fq;
#pragma unroll
        for (int ai = 0; ai < 2; ++ai)
#pragma unroll
            for (int m = 0; m < 4; ++m) { const int row = row0 + ai * HALF + m * 16; bf16_t* rowp = C + (size_t)row * ldc + col0; float s = 0.f;
#pragma unroll
                for (int bj = 0; bj < 2; ++bj) { const f32x4 v0 = acc[ai][bj][m][0], v1 = acc[ai][bj][m][1];
                    s += ((v0[0] * v0[0] + v0[1] * v0[1]) + (v0[2] * v0[2] + v0[3] * v0[3])) + ((v1[0] * v1[0] + v1[1] * v1[1]) + (v1[2] * v1[2] + v1[3] * v1[3]));
                    *(u32x4*)(rowp + bj * HALF) = pack8(v0, v1); }
                s += __shfl_xor(s, 16); s += __shfl_xor(s, 32);
                if (fq == 0) ss[(size_t)row * 64 + u.pn * 4 + wc] = s; }
    }
};

__device__ __forceinline__ float dpp_shr1(float x) { return __builtin_bit_cast(float, __builtin_amdgcn_update_dpp(0, __builtin_bit_cast(int, x), 0x111, 0xf, 0xf, true)); }
__device__ __forceinline__ float silu_f(float x) { return x * __builtin_amdgcn_rcpf(1.0f + __builtin_amdgcn_exp2f(x * -1.4426950408889634f)); }
struct EpiUp {
    static constexpr bool PERM = true, AFTER_DRAIN = false, AROWS4 = true;
    bf16_t* G; const float* wconv; bf16_t* edge;
    __device__ __forceinline__ void operator()(const f32x4 (&acc)[2][2][4][2], const Unit& u, int wr, int wc, int fr, int fq) const {
        const int f0 = u.pn * 128 + wc * 32 + 8 * fq;
        const int ce = u.pn * 256 + wc * 32 + 8 * fq;
        unsigned keep[2][4][2];
#pragma unroll
        for (int n = 0; n < 2; ++n) {
            f32x4 wg[3], wv[3];
#pragma unroll
            for (int j = 0; j < 3; ++j) { wg[j] = *(const f32x4*)(wconv + (size_t)j * EP_UPW + f0 + 4 * n); wv[j] = *(const f32x4*)(wconv + (size_t)j * EP_UPW + EP_DFF + f0 + 4 * n); }
#pragma unroll
            for (int ai = 0; ai < 2; ++ai) {
                const int blk = u.pm * 4 + ai * 2 + wr;
                const f32x4 g0 = acc[ai][0][0][n], g1 = acc[ai][0][1][n], g2 = acc[ai][0][2][n], g3 = acc[ai][0][3][n];
                const f32x4 v0 = acc[ai][1][0][n], v1 = acc[ai][1][1][n], v2 = acc[ai][1][2][n], v3 = acc[ai][1][3][n];
                f32x4 gm1, gm2, vm1, vm2;
#pragma unroll
                for (int j = 0; j < 4; ++j) { gm1[j] = dpp_shr1(g3[j]); gm2[j] = dpp_shr1(g2[j]); vm1[j] = dpp_shr1(v3[j]); vm2[j] = dpp_shr1(v2[j]); }
                const f32x4 cg[4] = { wg[2] * g0 + wg[1] * gm1 + wg[0] * gm2, wg[2] * g1 + wg[1] * g0 + wg[0] * gm1, wg[2] * g2 + wg[1] * g1 + wg[0] * g0, wg[2] * g3 + wg[1] * g2 + wg[0] * g1 };
                const f32x4 cv[4] = { wv[2] * v0 + wv[1] * vm1 + wv[0] * vm2, wv[2] * v1 + wv[1] * v0 + wv[0] * vm1, wv[2] * v2 + wv[1] * v1 + wv[0] * v0, wv[2] * v3 + wv[1] * v2 + wv[0] * v1 };
#pragma unroll
                for (int m = 0; m < 4; ++m) {
                    f32x4 o;
#pragma unroll
                    for (int j = 0; j < 4; ++j) o[j] = silu_f(cg[m][j]) * cv[m][j];
                    const unsigned w0 = cvt_pk_bf16(o[0], o[1]), w1 = cvt_pk_bf16(o[2], o[3]);
                    if (n == 0) { keep[ai][m][0] = w0; keep[ai][m][1] = w1; }
                    else { const int row = u.pm * BM + ai * HALF + wr * 64 + 4 * fr + m;
                        if (fr > 0 || m >= 2) { u32x4 w; w.x = keep[ai][m][0]; w.y = keep[ai][m][1]; w.z = w0; w.w = w1; *(u32x4*)(G + (size_t)row * EP_DFF + f0) = w; } }
                }
#define EDGE_ST(e_, g_, v_) do { *(unsigned long long*)(e_) = (unsigned long long)cvt_pk_bf16(g_[0], g_[1]) | ((unsigned long long)cvt_pk_bf16(g_[2], g_[3]) << 32); \
                        *(unsigned long long*)((e_) + 128) = (unsigned long long)cvt_pk_bf16(v_[0], v_[1]) | ((unsigned long long)cvt_pk_bf16(v_[2], v_[3]) << 32); } while (0)
                if (fr == 0) { bf16_t* e = edge + ((size_t)blk * 4 + 2) * EP_UPW + ce + 4 * n; EDGE_ST(e, g0, v0); EDGE_ST(e + EP_UPW, g1, v1); }
                if (fr == 15 && blk + 1 < 256) { bf16_t* e = edge + ((size_t)(blk + 1) * 4) * EP_UPW + ce + 4 * n; EDGE_ST(e, g2, v2); EDGE_ST(e + EP_UPW, g3, v3); }
#undef EDGE_ST
            }
        }
    }
};

template <class Epi, class Sched, bool ALIGN_EPI = false, bool SP2 = false>
__device__ __forceinline__ void gemm_phase(PG8_LAS unsigned char* lds, const Gemm g, const Sched& S, const Epi& E) {
    const int tid = opaque_tid(), wid = __builtin_amdgcn_readfirstlane(tid >> 6), lane = tid & 63, wr = wid >> 2, wc = wid & 3, fr = lane & 15, fq = lane >> 4;
    const int K = g.K, nt = K / BK;
    unsigned voffA[2], voffB[2];
#pragma unroll
    for (int i = 0; i < 2; ++i) { int R, C; stage_rc(tid * 16 + i * 8192, R, C); const int Rb = Epi::PERM ? ((R & ~31) + perm32(R & 31)) : R;
        const int Ra = Epi::AROWS4 ? ((R & ~63) + 4 * (R & 15) + ((R >> 4) & 3)) : R;
        voffA[i] = (unsigned)(Ra * K + C) * 2u; voffB[i] = (unsigned)(Rb * K + C) * 2u; }
    const size_t kstep = (size_t)(BK * 2);
    const size_t hstep = (size_t)HALF * K * 2;
    const size_t tstep = 2 * hstep;
    const unsigned ldsw = (unsigned)wid * 1024u;
    const int aoff = lds_byte(wr * 64 + fr, fq * 8), boff = lds_byte(wc * 32 + fr, fq * 8);
#define PG8_SA(b, h) (((b) * 2 + (h)) * HTB)
#define PG8_SB(b, h) ((4 + (b) * 2 + (h)) * HTB)
#define PG8_STAGE(bufoff, gbase, voff) do { _Pragma("unroll") for (int _i = 0; _i < 2; ++_i) \
        __builtin_amdgcn_global_load_lds((const unsigned*)((const char*)(gbase) + (voff)[_i]), (PG8_LAS unsigned*)(lds + (bufoff) + ldsw + _i * 8192), 16, 0, 0); } while (0)
#define PG8_LDA(dst, b, h) do { _Pragma("unroll") for (int m = 0; m < 4; ++m) _Pragma("unroll") for (int k = 0; k < 2; ++k) dst[m][k] = *(const PG8_LAS bf16x8*)(lds + PG8_SA(b, h) + aoff + m * 2048 + k * 1024); } while (0)
#define PG8_LDB(dst, b, h) do { _Pragma("unroll") for (int n = 0; n < 2; ++n) _Pragma("unroll") for (int k = 0; k < 2; ++k) dst[n][k] = *(const PG8_LAS bf16x8*)(lds + PG8_SB(b, h) + boff + n * 2048 + k * 1024); } while (0)
#define PG8_MMA(ai, bj, At, Bt) do { __builtin_amdgcn_s_setprio(1); _Pragma("unroll") for (int m = 0; m < 4; ++m) _Pragma("unroll") for (int n = 0; n < 2; ++n) _Pragma("unroll") for (int k = 0; k < 2; ++k) \
        acc[ai][bj][m][n] = __builtin_amdgcn_mfma_f32_16x16x32_bf16(Bt[n][k], At[m][k], acc[ai][bj][m][n], 0, 0, 0); __builtin_amdgcn_s_setprio(0); } while (0)
#define PG8_WAIT_V(n) asm volatile("s_waitcnt vmcnt(" #n ")" ::: "memory")
#define PG8_WAIT_L(n) asm volatile("s_waitcnt lgkmcnt(" #n ")" ::: "memory")
#define PG8_BAR __builtin_amdgcn_s_barrier()
#define PG8_SCHED __builtin_amdgcn_sched_barrier(0)
    Unit cur, nxt; int ui = 0;
    if (!S.next(0, cur)) return;
    f32x4 acc[2][2][4][2];
#pragma unroll
    for (int a = 0; a < 2; ++a)
#pragma unroll
        for (int b = 0; b < 2; ++b)
#pragma unroll
            for (int m = 0; m < 4; ++m)
#pragma unroll
                for (int n = 0; n < 2; ++n) acc[a][b][m][n] = (f32x4){0.f, 0.f, 0.f, 0.f};
    bf16x8 At[4][2], B0[2][2], B1[2][2];
    const char* cA = (const char*)g.A + (size_t)cur.pm * tstep; const char* cB = (const char*)g.Bt + (size_t)cur.pn * tstep;
    S.a_ready(cur);
    if constexpr (SP2) {
        PG8_STAGE(PG8_SB(0, 0), cB, voffB); PG8_STAGE(PG8_SB(0, 1), cB + hstep, voffB); PG8_STAGE(PG8_SA(0, 0), cA, voffA); PG8_STAGE(PG8_SA(0, 1), cA + hstep, voffA);
        if (wr == 1) PG8_BAR;
        PG8_WAIT_V(2); PG8_BAR;
        PG8_STAGE(PG8_SB(1, 0), cB + kstep, voffB); PG8_STAGE(PG8_SA(1, 0), cA + kstep, voffA); PG8_STAGE(PG8_SB(1, 1), cB + hstep + kstep, voffB);
        PG8_WAIT_V(6); PG8_BAR;
    } else {
        PG8_STAGE(PG8_SB(0, 0), cB, voffB); PG8_STAGE(PG8_SA(0, 0), cA, voffA); PG8_STAGE(PG8_SB(0, 1), cB + hstep, voffB); PG8_STAGE(PG8_SA(0, 1), cA + hstep, voffA);
        if (wr == 1) PG8_BAR;
        PG8_WAIT_V(4); PG8_BAR;
        PG8_STAGE(PG8_SB(1, 0), cB + kstep, voffB); PG8_STAGE(PG8_SA(1, 0), cA + kstep, voffA); PG8_STAGE(PG8_SB(1, 1), cB + hstep + kstep, voffB);
        PG8_WAIT_V(6); PG8_BAR;
    }
    for (;;) {
        const bool has_next = S.next(ui + 1, nxt);
        const char* nA = has_next ? (const char*)g.A + (size_t)nxt.pm * tstep : cA; const char* nB = has_next ? (const char*)g.Bt + (size_t)nxt.pn * tstep : cB;
        for (int t = 0; t < nt; t += 2) {
            const bool last = (t == nt - 2);
            const char* a1 = cA + (size_t)(t + 1) * kstep;
            const char* a2 = last ? nA : cA + (size_t)(t + 2) * kstep; const char* b2 = last ? nB : cB + (size_t)(t + 2) * kstep;
            const char* a3 = a2 + kstep; const char* b3 = b2 + kstep;
            if (last && has_next) S.a_ready(nxt);
            if constexpr (SP2) {
            PG8_LDB(B0, 0, 0); PG8_LDB(B1, 0, 1); PG8_SCHED; PG8_LDA(At, 0, 0); PG8_STAGE(PG8_SA(1, 1), a1 + hstep, voffA);
            PG8_WAIT_V(8); PG8_WAIT_L(0); PG8_BAR; PG8_MMA(0, 0, At, B0); PG8_MMA(0, 1, At, B1); PG8_BAR; PG8_SCHED;
            PG8_LDA(At, 0, 1); PG8_STAGE(PG8_SB(0, 0), b2, voffB); PG8_STAGE(PG8_SB(0, 1), b2 + hstep, voffB); PG8_STAGE(PG8_SA(0, 0), a2, voffA);
            PG8_WAIT_V(8); PG8_WAIT_L(0); PG8_BAR; PG8_MMA(1, 0, At, B0); PG8_MMA(1, 1, At, B1); PG8_BAR; PG8_SCHED;
            PG8_LDB(B0, 1, 0); PG8_LDB(B1, 1, 1); PG8_SCHED; PG8_LDA(At, 1, 0); PG8_STAGE(PG8_SA(0, 1), a2 + hstep, voffA);
            PG8_WAIT_V(8); PG8_WAIT_L(0); PG8_BAR; PG8_MMA(0, 0, At, B0); PG8_MMA(0, 1, At, B1); PG8_BAR; PG8_SCHED;
            PG8_LDA(At, 1, 1); PG8_STAGE(PG8_SB(1, 0), b3, voffB); PG8_STAGE(PG8_SB(1, 1), b3 + hstep, voffB); PG8_STAGE(PG8_SA(1, 0), a3, voffA);
            PG8_WAIT_V(8); PG8_WAIT_L(0); PG8_BAR; PG8_MMA(1, 0, At, B0); PG8_MMA(1, 1, At, B1); PG8_BAR; PG8_SCHED;
            } else {
            PG8_LDB(B0, 0, 0); PG8_SCHED; PG8_LDA(At, 0, 0); PG8_STAGE(PG8_SA(1, 1), a1 + hstep, voffA);
            PG8_WAIT_L(8); PG8_BAR; PG8_WAIT_L(0); PG8_MMA(0, 0, At, B0); PG8_BAR; PG8_SCHED;
            PG8_LDB(B1, 0, 1); PG8_STAGE(PG8_SB(0, 0), b2, voffB);
            PG8_BAR; PG8_WAIT_L(0); PG8_MMA(0, 1, At, B1); PG8_BAR;
            PG8_LDA(At, 0, 1); PG8_STAGE(PG8_SA(0, 0), a2, voffA);
            PG8_BAR; PG8_WAIT_L(0); PG8_MMA(1, 0, At, B0); PG8_BAR; PG8_SCHED;
            PG8_STAGE(PG8_SB(0, 1), b2 + hstep, voffB);
            PG8_WAIT_V(6); PG8_BAR; PG8_MMA(1, 1, At, B1); PG8_BAR;
            PG8_LDB(B0, 1, 0); PG8_SCHED; PG8_LDA(At, 1, 0); PG8_STAGE(PG8_SA(0, 1), a2 + hstep, voffA);
            PG8_WAIT_L(8); PG8_BAR; PG8_WAIT_L(0); PG8_MMA(0, 0, At, B0); PG8_BAR; PG8_SCHED;
            PG8_LDB(B1, 1, 1); PG8_STAGE(PG8_SB(1, 0), b3, voffB);
            PG8_BAR; PG8_WAIT_L(0); PG8_MMA(0, 1, At, B1); PG8_BAR;
            PG8_LDA(At, 1, 1); PG8_STAGE(PG8_SA(1, 0), a3, voffA);
            PG8_BAR; PG8_WAIT_L(0); PG8_MMA(1, 0, At, B0); PG8_BAR; PG8_SCHED;
            PG8_STAGE(PG8_SB(1, 1), b3 + hstep, voffB);
            PG8_WAIT_V(6); PG8_BAR; PG8_MMA(1, 1, At, B1); PG8_BAR;
            }
        }
        if constexpr (ALIGN_EPI) { if (wr == 0) PG8_BAR; }
        if constexpr (!Epi::AFTER_DRAIN) { E(acc, cur, wr, wc, fr, fq); S.done(cur); }
        if (!has_next) break;
#pragma unroll
        for (int a = 0; a < 2; ++a)
#pragma unroll
            for (int b = 0; b < 2; ++b)
#pragma unroll
                for (int m = 0; m < 4; ++m)
#pragma unroll
                    for (int n = 0; n < 2; ++n) acc[a][b][m][n] = (f32x4){0.f, 0.f, 0.f, 0.f};
        cur = nxt; cA = nA; cB = nB; ++ui;
        if constexpr (ALIGN_EPI) { if (wr == 1) PG8_BAR; }
    }
    PG8_WAIT_V(0);
    if constexpr (!ALIGN_EPI) { if (wr == 0) PG8_BAR; }
    PG8_BAR;
    if constexpr (Epi::AFTER_DRAIN) { E.fused(acc, cur, wr, wc, fr, fq, lds, wid, lane); S.done(cur); }
#undef PG8_SA
#undef PG8_SB
#undef PG8_STAGE
#undef PG8_LDA
#undef PG8_LDB
#undef PG8_MMA
#undef PG8_WAIT_V
#undef PG8_WAIT_L
#undef PG8_BAR
#undef PG8_SCHED
}
}
namespace att {
enum { ORDER_NATURAL = 0, ORDER_REVERSED = 1, ORDER_PAIRED = 2, ORDER_XCD = 4 };
constexpr int D = 128, PITCH = 2048;
constexpr float THR = 8.f;
constexpr bool WSKIP = false;
constexpr float SCALE = 0.08838834764831845f;
constexpr int NW = 8, QBLK = 32, KVBLK = 64, QB = NW * QBLK;
constexpr int SHM_V = KVBLK * D * 2, SHM_K = KVBLK * D * 2;
constexpr int LDS_BYTES = 2 * SHM_V + 2 * SHM_K + NW * 64 * 4;
using bf16 = __hip_bfloat16;
typedef short bf16x8 __attribute__((ext_vector_type(8)));
typedef short s16x4 __attribute__((ext_vector_type(4)));
typedef float f32x16 __attribute__((ext_vector_type(16)));
typedef float f32x4 __attribute__((ext_vector_type(4)));
typedef unsigned u32x4 __attribute__((ext_vector_type(4)));
template <class A, class Bt> struct same_t { static constexpr bool v = false; };
template <class A> struct same_t<A, A> { static constexpr bool v = true; };

#define KSWZ(row, colB) ((row) * 256 + ((colB) ^ (((row) & 7) << 4)))
#define SBAR() __builtin_amdgcn_sched_barrier(0)
__device__ __forceinline__ int v_st(int k, int c) { const int kk = (k & ~0xC) | ((k & 4) << 1) | ((k & 8) >> 1); return ((kk >> 3) * 4 + (c >> 5)) * 512 + ((kk & 7) * 32 + (c & 31)) * 2; }
__device__ __forceinline__ int v_rd_base(int lane) { return ((lane & 3) << 3) | (((lane >> 2) & 3) << 6) | (((lane >> 4) & 1) << 5) | (((lane >> 5) & 1) << 8); }
constexpr int v_rd_off(int d0, int ks, int half) { return d0 * 512 + ks * 4096 + half * 2048; }
__device__ __forceinline__ int crow(int r, int hi) { return (r & 3) + 8 * (r >> 2) + 4 * hi; }
__device__ __forceinline__ unsigned cvtpk(float lo, float hi) {
    unsigned r; asm volatile("v_cvt_pk_bf16_f32 %0, %1, %2" : "=v"(r) : "v"(lo), "v"(hi)); return r;
}
__device__ __forceinline__ bf16x8 pack8(f32x4 a, f32x4 b) {
    u32x4 w = {cvtpk(a[0], a[1]), cvtpk(a[2], a[3]), cvtpk(b[0], b[1]), cvtpk(b[2], b[3])};
    return *reinterpret_cast<bf16x8*>(&w);
}
template <class T> __device__ __forceinline__ bf16x8 load8(const T* p) {
    if constexpr (same_t<T, float>::v) { return pack8(*(const f32x4*)p, *(const f32x4*)(p + 4)); }
    else { return *reinterpret_cast<const bf16x8*>(p); }
}
__device__ __forceinline__ void mask_tile(f32x16& p0, f32x16& p1, int dq, unsigned W) {
    const float NEG = -__builtin_inff();
#pragma unroll
    for (int r = 0; r < 16; ++r) {
        const int c = (r & 3) + 8 * (r >> 2);
        if ((unsigned)(dq - c) >= W) p0[r] = NEG;
        if ((unsigned)(dq - c - 32) >= W) p1[r] = NEG;
    }
}
__device__ __forceinline__ void partialSM(f32x16& p0, f32x16& p1, float& m_reg, float& mn, float& alpha) {
    float pmax = p0[0]; for (int r = 1; r < 16; ++r) pmax = fmaxf(pmax, p0[r]); for (int r = 0; r < 16; ++r) pmax = fmaxf(pmax, p1[r]);
    { auto rr = __builtin_amdgcn_permlane32_swap(__float_as_uint(pmax), __float_as_uint(pmax), false, false);
      pmax = fmaxf(__uint_as_float(rr[0]), __uint_as_float(rr[1])); }
    constexpr float C2 = 1.4426950408889634f * SCALE;
    if (__builtin_expect(__all((pmax - m_reg) * SCALE <= THR), 1)) { mn = m_reg; alpha = 1.f; }
    else { mn = fmaxf(m_reg, pmax); alpha = __builtin_amdgcn_exp2f((m_reg - mn) * C2); m_reg = mn; }
    const float mnL = -mn * C2;
    for (int r = 0; r < 16; ++r) p0[r] = fmaf(p0[r], C2, mnL); for (int r = 0; r < 16; ++r) p1[r] = fmaf(p1[r], C2, mnL);
    for (int r = 0; r < 16; ++r) p0[r] = __builtin_amdgcn_exp2f(p0[r]);
}
__device__ __forceinline__ void finishSM(f32x16& p0, f32x16& p1, float alpha, float& l_reg, bf16x8& pa0, bf16x8& pa1, bf16x8& pa2, bf16x8& pa3) {
    for (int r = 0; r < 16; ++r) p1[r] = __builtin_amdgcn_exp2f(p1[r]);
    float ps = 0; for (int r = 0; r < 16; ++r) ps += p0[r]; for (int r = 0; r < 16; ++r) ps += p1[r];
    { auto rr = __builtin_amdgcn_permlane32_swap(__float_as_uint(ps), __float_as_uint(ps), false, false);
      ps = __uint_as_float(rr[0]) + __uint_as_float(rr[1]); }
    l_reg = l_reg * alpha + ps;
#define PK4(P, B_, OUT) do { unsigned a0 = cvtpk(P[B_+0], P[B_+1]), a1 = cvtpk(P[B_+2], P[B_+3]);                          \
        unsigned b0 = cvtpk(P[B_+4], P[B_+5]), b1 = cvtpk(P[B_+6], P[B_+7]);                                             \
        auto r0 = __builtin_amdgcn_permlane32_swap(a0, b0, false, false); auto r1 = __builtin_amdgcn_permlane32_swap(a1, b1, false, false); \
        u32x4 w = {r0[0], r1[0], r0[1], r1[1]}; OUT = *reinterpret_cast<bf16x8*>(&w); } while (0)
    PK4(p0, 0, pa0); PK4(p0, 8, pa1); PK4(p1, 0, pa2); PK4(p1, 8, pa3);
#undef PK4
}
template <int KB, bool SK>
__device__ __forceinline__ void qkt(f32x16& p0, f32x16& p1, const char* K_lds, int r32, int hi, const bf16x8* qr, bool act) {
    if (SK && !act) { const float NEG = -__builtin_inff();
#pragma unroll
        for (int r = 0; r < 16; ++r) { p0[r] = NEG; p1[r] = NEG; } return; }
    p0 = f32x16{}; p1 = f32x16{};
    const char* kb[4];
#pragma unroll
    for (int dd = 0; dd < 4; ++dd) kb[dd] = K_lds + KB * SHM_K + KSWZ(r32, (dd * 16 + hi * 8) * 2);
#pragma unroll
    for (int d0 = 0; d0 < 8; ++d0) { const char* a = kb[d0 & 3] + (d0 >> 2) * 128;
        bf16x8 b0 = *reinterpret_cast<const bf16x8*>(a);
        bf16x8 b1 = *reinterpret_cast<const bf16x8*>(a + 32 * 256);
        p0 = __builtin_amdgcn_mfma_f32_32x32x16_bf16(b0, qr[d0], p0, 0, 0, 0);
        p1 = __builtin_amdgcn_mfma_f32_32x32x16_bf16(b1, qr[d0], p1, 0, 0, 0); }
}
template <int VB, bool SK>
__device__ __forceinline__ void pv_tile(f32x16* o, int vb0, bf16x8 pa0, bf16x8 pa1, bf16x8 pa2, bf16x8 pa3, bool act) {
    if (SK && !act) return;
#define TRRD(dst, off) asm volatile("ds_read_b64_tr_b16 %0, %1 offset:%2" : "=&v"(dst) : "v"(vb0), "i"(off) : "memory")
#define PV_D0(d0) do { s16x4 l0, l1, l2, l3, h0, h1, h2, h3; constexpr int b_ = VB * SHM_V + v_rd_off(d0, 0, 0);     \
        TRRD(l0, b_); TRRD(h0, b_ + 2048); TRRD(l1, b_ + 4096); TRRD(h1, b_ + 6144); TRRD(l2, b_ + 8192); TRRD(h2, b_ + 10240); TRRD(l3, b_ + 12288); TRRD(h3, b_ + 14336); \
        asm volatile("s_waitcnt lgkmcnt(0)" ::: "memory"); SBAR();                 \
        o[d0] = __builtin_amdgcn_mfma_f32_32x32x16_bf16(pa0, (bf16x8){l0[0], l0[1], l0[2], l0[3], h0[0], h0[1], h0[2], h0[3]}, o[d0], 0, 0, 0);   \
        o[d0] = __builtin_amdgcn_mfma_f32_32x32x16_bf16(pa1, (bf16x8){l1[0], l1[1], l1[2], l1[3], h1[0], h1[1], h1[2], h1[3]}, o[d0], 0, 0, 0);   \
        o[d0] = __builtin_amdgcn_mfma_f32_32x32x16_bf16(pa2, (bf16x8){l2[0], l2[1], l2[2], l2[3], h2[0], h2[1], h2[2], h2[3]}, o[d0], 0, 0, 0);   \
        o[d0] = __builtin_amdgcn_mfma_f32_32x32x16_bf16(pa3, (bf16x8){l3[0], l3[1], l3[2], l3[3], h3[0], h3[1], h3[2], h3[3]}, o[d0], 0, 0, 0); } while (0)
    PV_D0(0); PV_D0(1); PV_D0(2); PV_D0(3);
#undef PV_D0
#undef TRRD
}

template <class TIn, class TOut> struct BlockRef { const TIn* Q; const TIn* K; const TIn* V; TOut* O; int P0; };
template <class TIn> struct Seam {
    bf16x8 qr[8];
    bf16x8 st_v0, st_v1, st_k0, st_k1; f32x4 sf0, sf1, sf2, sf3;
    f32x4 tq[16];
};
__device__ __forceinline__ int swa_jlo(int P0, int W) { const int lowk = P0 - W + 1; return lowk > 0 ? lowk / KVBLK : 0; }
#define ROW(p, k0, rr) ((p) + (size_t)((k0) + (rr)) * PITCH + sc)
#define VMW() asm volatile("s_waitcnt vmcnt(0)" ::: "memory")
#define VMWN(n) asm volatile("s_waitcnt vmcnt(%0)" :: "i"(n) : "memory")
#define SLOAD_H(Kp, Vp, k0) do { S.st_v0 = load8<TIn>(ROW(Vp, k0, sr)); S.st_v1 = load8<TIn>(ROW(Vp, k0, 32 + sr));              \
                         S.st_k0 = load8<TIn>(ROW(Kp, k0, sr)); S.st_k1 = load8<TIn>(ROW(Kp, k0, 32 + sr)); } while (0)
#define SWRITE_HK(bf) do { *(bf16x8*)(K_lds + (bf) * SHM_K + kws) = S.st_k0; *(bf16x8*)(K_lds + (bf) * SHM_K + kws + 32 * 256) = S.st_k1; } while (0)
#define SWRITE_HV(bf) do { *(bf16x8*)(V_lds + (bf) * SHM_V + vst0) = S.st_v0; *(bf16x8*)(V_lds + (bf) * SHM_V + vst1) = S.st_v1; } while (0)
#define SWRITE_H(bf) do { SWRITE_HV(bf); SWRITE_HK(bf); } while (0)
#define SLOAD_F(p, k0) do { S.sf0 = *(const f32x4*)ROW(p, k0, sr); S.sf1 = *(const f32x4*)(ROW(p, k0, sr) + 4);                \
                            S.sf2 = *(const f32x4*)ROW(p, k0, 32 + sr); S.sf3 = *(const f32x4*)(ROW(p, k0, 32 + sr) + 4); } while (0)
#define SWRITE_KF(bf) do { *(bf16x8*)(K_lds + (bf) * SHM_K + kws) = pack8(S.sf0, S.sf1); *(bf16x8*)(K_lds + (bf) * SHM_K + kws + 32 * 256) = pack8(S.sf2, S.sf3); } while (0)
#define SWRITE_VF(bf) do { *(bf16x8*)(V_lds + (bf) * SHM_V + vst0) = pack8(S.sf0, S.sf1); *(bf16x8*)(V_lds + (bf) * SHM_V + vst1) = pack8(S.sf2, S.sf3); } while (0)
template <class TIn, class TOut>
__device__ __forceinline__ void causal_swa_prime(const BlockRef<TIn, TOut>& cur, int W, char* lds, Seam<TIn>& S) {
    constexpr bool F32 = same_t<TIn, float>::v;
    const int tid = opaque_tid(), wid = __builtin_amdgcn_readfirstlane(tid >> 6), lane = tid & 63, r32 = lane & 31, hi = lane >> 5;
    const int sr = tid >> 4, sc = (tid & 15) * 8, kws = KSWZ(sr, sc * 2); char* K_lds = lds + 2 * SHM_V;
    const int kb0 = swa_jlo(cur.P0, W) * KVBLK;
    for (int d0 = 0; d0 < 8; ++d0) S.qr[d0] = load8<TIn>(cur.Q + (size_t)(wid * QBLK + r32) * PITCH + d0 * 16 + hi * 8);
    if constexpr (F32) { SLOAD_F((const float*)cur.K, kb0); VMW(); SWRITE_KF(0); SBAR(); SLOAD_F((const float*)cur.V, kb0); }
    else { SLOAD_H(cur.K, cur.V, kb0); VMW(); SWRITE_HK(0); }
    __syncthreads();
}
template <class TIn, class TOut>
__device__ __forceinline__ void causal_swa_block(const BlockRef<TIn, TOut>& cur, const BlockRef<TIn, TOut>& nxt, int skv, int W, char* lds, Seam<TIn>& S) {
    constexpr bool F32 = same_t<TIn, float>::v;
    const int tid = opaque_tid(), wid = __builtin_amdgcn_readfirstlane(tid >> 6), lane = tid & 63, r32 = lane & 31, hi = lane >> 5;
    const int j_lo = swa_jlo(cur.P0, W);
    int j_hi = (cur.P0 + QB - 1) / KVBLK + 1; if (j_hi > skv / KVBLK) j_hi = skv / KVBLK;
    const int NT = j_hi - j_lo;
    const int kbn = swa_jlo(nxt.P0, W) * KVBLK;
    const int qlo = cur.P0 + wid * QBLK, qm = qlo + r32 - 4 * hi;
    char* V_lds = lds; char* K_lds = lds + 2 * SHM_V;
    float* ws = (float*)(lds + 2 * SHM_V + 2 * SHM_K) + wid * 64; float* li_l = ws, * al_l = ws + 32;
    float m_reg = -1e30f, l_reg = 0; f32x16 o[4] = {};
    const int sr = tid >> 4, sc = (tid & 15) * 8, vst0 = v_st(sr, sc), vst1 = v_st(32 + sr, sc), kws = KSWZ(sr, sc * 2);
    const int vb0 = (int)(uintptr_t)V_lds + v_rd_base(lane);
    const TIn* Kh = cur.K; const TIn* Vh = cur.V;
#define RESC(a) do { if (__any((a) < 1.f)) { if (hi == 0) al_l[r32] = (a); asm volatile("s_waitcnt lgkmcnt(0)" ::: "memory");              \
                     for (int d_ = 0; d_ < 4; ++d_) for (int r = 0; r < 16; ++r) o[d_][r] *= al_l[crow(r, hi)]; } } while (0)
#define KBASE(t) ((j_lo + (t)) * KVBLK)
#define ACT(t) (KBASE(t) <= qlo + QBLK - 1 && KBASE(t) + KVBLK - 1 >= qlo - W + 1)
#define MASKT(P0_, P1_, t) do { const int kb_ = KBASE(t); if ((!SK || ACT(t)) && (kb_ + KVBLK - 1 > qlo || kb_ <= qlo + QBLK - 1 - W)) mask_tile(P0_, P1_, qm - kb_, (unsigned)W); } while (0)
    constexpr int NQL = F32 ? 16 : 8;
    constexpr bool SK = WSKIP && !F32;
#define SEAM_K0() do { VMWN(NQL); if constexpr (F32) { SWRITE_KF(0); SBAR(); SLOAD_F((const float*)nxt.V, kbn); } else { SWRITE_HK(0); } SBAR(); } while (0)
    f32x16 pA0, pA1, pB0, pB1; float mnA, mnB, alA, alB; bf16x8 pa0, pa1, pa2, pa3;
    if constexpr (F32) { VMW(); SWRITE_VF(0); SBAR(); } else { SWRITE_HV(0); SBAR(); }
    if (NT > 1) { if constexpr (F32) SLOAD_F((const float*)Kh, KBASE(1)); else SLOAD_H(Kh, Vh, KBASE(1)); }
    SBAR(); qkt<0, SK>(pA0, pA1, K_lds, r32, hi, S.qr, ACT(0));
    if constexpr (F32) { if (NT > 1) { VMW(); SWRITE_KF(1); SBAR(); SLOAD_F((const float*)Vh, KBASE(1)); } }
    MASKT(pA0, pA1, 0); partialSM(pA0, pA1, m_reg, mnA, alA);
    if (NT > 1) { VMW(); if constexpr (F32) { SWRITE_VF(1); SBAR(); if (NT > 2) SLOAD_F((const float*)Kh, KBASE(2)); } else SWRITE_H(1); }
    __syncthreads();
#define HALF_STEP(PX0, PX1, mnX, alX, PY0, PY1, alY, t, KB, VB, SB) do {                                                      \
        SBAR(); qkt<KB, SK>(PX0, PX1, K_lds, r32, hi, S.qr, ACT(t));                                             \
        finishSM(PY0, PY1, alY, l_reg, pa0, pa1, pa2, pa3); SBAR();                                                           \
        if ((t) + 1 < NT) { if constexpr (F32) { VMW(); SWRITE_KF(SB); SBAR(); SLOAD_F((const float*)Vh, KBASE((t) + 1)); }  \
                            else { SLOAD_H(Kh, Vh, KBASE((t) + 1)); } SBAR(); }                                               \
        pv_tile<VB, SK>(o, vb0, pa0, pa1, pa2, pa3, ACT((t) - 1)); MASKT(PX0, PX1, (t)); partialSM(PX0, PX1, m_reg, mnX, alX);                                        \
        __syncthreads();                                                                                                      \
        if ((t) + 1 < NT) { VMW(); if constexpr (F32) { SWRITE_VF(SB); SBAR(); if ((t) + 2 < NT) SLOAD_F((const float*)Kh, KBASE((t) + 2)); } \
                            else { SWRITE_H(SB); } }                                                                          \
        RESC(alX); __syncthreads(); } while (0)
    for (int t = 1; t + 1 < NT; t += 2) {
        HALF_STEP(pB0, pB1, mnB, alB, pA0, pA1, alA, t, 1, 0, 0);
        HALF_STEP(pA0, pA1, mnA, alA, pB0, pB1, alB, t + 1, 0, 1, 1);
    }
    const bool even = (NT & 1) == 0;
    if (even) { SBAR(); qkt<1, SK>(pB0, pB1, K_lds, r32, hi, S.qr, ACT(NT - 1)); SBAR(); }
#define QROW(e) (nxt.Q + (size_t)(wid * QBLK + r32) * PITCH + ((e) >> 1) * 16 + hi * 8 + ((e) & 1) * 4)
    if constexpr (F32) { SLOAD_F((const float*)nxt.K, kbn); SBAR();
#pragma unroll
        for (int e = 0; e < 8; ++e) S.tq[e] = *(const f32x4*)QROW(e); }
    else { SLOAD_H(nxt.K, nxt.V, kbn); SBAR();
#pragma unroll
        for (int d0 = 0; d0 < 8; ++d0) S.qr[d0] = load8<TIn>(nxt.Q + (size_t)(wid * QBLK + r32) * PITCH + d0 * 16 + hi * 8); }
    SBAR();
    finishSM(pA0, pA1, alA, l_reg, pa0, pa1, pa2, pa3); SBAR();
    if constexpr (F32) {
#pragma unroll
        for (int e = 8; e < 16; ++e) S.tq[e] = *(const f32x4*)QROW(e); SBAR(); }
#undef QROW
    pv_tile<0, SK>(o, vb0, pa0, pa1, pa2, pa3, ACT(even ? NT - 2 : NT - 1));
    if (even) { MASKT(pB0, pB1, NT - 1); partialSM(pB0, pB1, m_reg, mnB, alB); __syncthreads(); RESC(alB);
        finishSM(pB0, pB1, alB, l_reg, pa0, pa1, pa2, pa3); SBAR(); pv_tile<1, SK>(o, vb0, pa0, pa1, pa2, pa3, ACT(NT - 1)); }
    SBAR(); SEAM_K0();
    if (hi == 0) li_l[r32] = l_reg; asm volatile("s_waitcnt lgkmcnt(0)" ::: "memory");
    float rli[16];
#pragma unroll
    for (int r = 0; r < 16; ++r) rli[r] = __builtin_amdgcn_rcpf(li_l[crow(r, hi)]);
    TOut* Ow = cur.O + (size_t)(wid * QBLK) * PITCH;
#pragma unroll
    for (int r = 0; r < 16; ++r) { const int orow = crow(r, hi);
#pragma unroll
        for (int d0 = 0; d0 < 4; ++d0) { const float v = o[d0][r] * rli[r];
            if constexpr (same_t<TOut, float>::v) { Ow[(size_t)orow * PITCH + d0 * 32 + r32] = v; }
            else { const float vn = __shfl_xor(v, 1);
                   if ((r32 & 1) == 0) *(unsigned*)(Ow + (size_t)orow * PITCH + d0 * 32 + r32) = cvtpk(v, vn); } } }
    if constexpr (F32) {
#pragma unroll
        for (int d0 = 0; d0 < 8; ++d0) S.qr[d0] = pack8(S.tq[2 * d0], S.tq[2 * d0 + 1]); }
    __syncthreads();
#undef RESC
#undef KBASE
#undef ACT
#undef MASKT
#undef SEAM_K0
#undef HALF_STEP
}
#undef ROW
#undef VMW
#undef VMWN
#undef SLOAD_H
#undef SWRITE_HK
#undef SWRITE_HV
#undef SWRITE_H
#undef SLOAD_F
#undef SWRITE_KF
#undef SWRITE_VF

__host__ __device__ inline int swa_nx(int nqb, int nramp, int order) { return (order & ORDER_PAIRED) ? (nramp + 1) / 2 + (nqb - nramp) : nqb; }
struct SwaItem { int bh, qb0, qb1; };
__device__ __forceinline__ SwaItem swa_decode(int L, int nb, int nh, int nhkv, int nqb, int nx, int nramp, int order) {
    const int G = nh / nhkv; SwaItem it; int x;
    if ((order & ORDER_XCD) && (nb * nhkv) % 8 == 0) { const int xcd = L & 7, k = L >> 3, per = G * nx, gi = k / per, r = k - gi * per;
        it.bh = (gi * 8 + xcd) * G + r / nx; x = r % nx; }
    else { it.bh = L / nx; x = L - it.bh * nx; }
    if (order & ORDER_PAIRED) { const int ns = nqb - nramp;
        if (x < ns) { it.qb0 = it.qb1 = nqb - 1 - x; } else { it.qb0 = x - ns; it.qb1 = nramp - 1 - it.qb0; } }
    else { it.qb0 = it.qb1 = ((order & 3) == ORDER_REVERSED) ? nqb - 1 - x : x; }
    return it;
}
}
namespace dat {
using namespace att;
#define DLAS __attribute__((address_space(3)))
constexpr int QB2 = 256;
constexpr int L_K = 0, L_V = 32768, L_AL = 131072, L_END = 133120;
constexpr float C2 = 1.4426950408889634f * SCALE;
constexpr int MXP = 4096;
struct Blk { const bf16* Q; const bf16* K; const bf16* V; bf16* S1; bf16* MX; const float* gsub; float lam; int j, mode; };

template <bool PIPE> __device__ __forceinline__ void pv_half(f32x16* o, int vb0, bf16x8 pa0, bf16x8 pa1, bf16x8 pa2, bf16x8 pa3) {
#define TRRD(dst, off) asm volatile("ds_read_b64_tr_b16 %0, %1 offset:%2" : "=&v"(dst) : "v"(vb0), "i"(off) : "memory")
#define PV_RD(d0, S) do { constexpr int b_ = v_rd_off(d0, 0, 0); TRRD(S##l0, b_); TRRD(S##h0, b_ + 2048); TRRD(S##l1, b_ + 4096); TRRD(S##h1, b_ + 6144); TRRD(S##l2, b_ + 8192); TRRD(S##h2, b_ + 10240); TRRD(S##l3, b_ + 12288); TRRD(S##h3, b_ + 14336); } while (0)
#define PV_MM(d0, S) do { \
        o[d0] = __builtin_amdgcn_mfma_f32_32x32x16_bf16((bf16x8){S##l0[0], S##l0[1], S##l0[2], S##l0[3], S##h0[0], S##h0[1], S##h0[2], S##h0[3]}, pa0, o[d0], 0, 0, 0); \
        o[d0] = __builtin_amdgcn_mfma_f32_32x32x16_bf16((bf16x8){S##l1[0], S##l1[1], S##l1[2], S##l1[3], S##h1[0], S##h1[1], S##h1[2], S##h1[3]}, pa1, o[d0], 0, 0, 0); \
        o[d0] = __builtin_amdgcn_mfma_f32_32x32x16_bf16((bf16x8){S##l2[0], S##l2[1], S##l2[2], S##l2[3], S##h2[0], S##h2[1], S##h2[2], S##h2[3]}, pa2, o[d0], 0, 0, 0); \
        o[d0] = __builtin_amdgcn_mfma_f32_32x32x16_bf16((bf16x8){S##l3[0], S##l3[1], S##l3[2], S##l3[3], S##h3[0], S##h3[1], S##h3[2], S##h3[3]}, pa3, o[d0], 0, 0, 0); } while (0)
    if constexpr (PIPE) {
    s16x4 al0, al1, al2, al3, ah0, ah1, ah2, ah3, bl0, bl1, bl2, bl3, bh0, bh1, bh2, bh3;
    PV_RD(0, a); PV_RD(1, b);
    asm volatile("s_waitcnt lgkmcnt(8)" ::: "memory"); SBAR(); PV_MM(0, a); SBAR();
    PV_RD(2, a);
    asm volatile("s_waitcnt lgkmcnt(8)" ::: "memory"); SBAR(); PV_MM(1, b); SBAR();
    PV_RD(3, b);
    asm volatile("s_waitcnt lgkmcnt(8)" ::: "memory"); SBAR(); PV_MM(2, a); SBAR();
    asm volatile("s_waitcnt lgkmcnt(0)" ::: "memory"); SBAR(); PV_MM(3, b);
    } else {
    s16x4 al0, al1, al2, al3, ah0, ah1, ah2, ah3;
    PV_RD(0, a); asm volatile("s_waitcnt lgkmcnt(0)" ::: "memory"); SBAR(); PV_MM(0, a); SBAR();
    PV_RD(1, a); asm volatile("s_waitcnt lgkmcnt(0)" ::: "memory"); SBAR(); PV_MM(1, a); SBAR();
    PV_RD(2, a); asm volatile("s_waitcnt lgkmcnt(0)" ::: "memory"); SBAR(); PV_MM(2, a); SBAR();
    PV_RD(3, a); asm volatile("s_waitcnt lgkmcnt(0)" ::: "memory"); SBAR(); PV_MM(3, a);
    }
#undef PV_MM
#undef PV_RD
#undef TRRD
}

__device__ __forceinline__ void diff_attn_block(const Blk& B, DLAS unsigned char* lds) {
    const int tid = opaque_tid(), wid = __builtin_amdgcn_readfirstlane(tid >> 6), lane = tid & 63, r32 = lane & 31, hi = lane >> 5;
    const int pr = wid; const bool grpB = wid >= 4;
    const int NT = 4 * (B.j + 1);
    const int qlo = QB2 * B.j + 32 * pr;
    int ksrc[2], vsrc[2];
#pragma unroll
    for (int i = 0; i < 2; ++i) { const int q = wid + 8 * i;
        const int row = 4 * q + (lane >> 4), cs = (lane & 15) ^ (row & 7); ksrc[i] = row * PITCH + cs * 8;
        const int ci = 64 * q + lane, sub = ci >> 5, within = ci & 31, kk = (sub >> 2) * 8 + (within >> 2), key = (kk & ~0xC) | ((kk & 4) << 1) | ((kk & 8) >> 1), c = (sub & 3) * 32 + (within & 3) * 8;
        vsrc[i] = key * PITCH + c; }
    DLAS unsigned char* const Kl = lds + L_K; DLAS unsigned char* const Vl = lds + L_V;
    const int vbase = (int)(unsigned)(size_t)Vl + v_rd_base(lane);
    const int kq = KSWZ(r32, hi * 16);
    bf16x8 qr[8];
#pragma unroll
    for (int d0 = 0; d0 < 8; ++d0) qr[d0] = *reinterpret_cast<const bf16x8*>(B.Q + (size_t)(32 * pr + r32) * PITCH + d0 * 16 + hi * 8);
#define DA_GLDS(gp, ldsoff) __builtin_amdgcn_global_load_lds((const unsigned*)(gp), (DLAS unsigned*)(lds + (ldsoff)), 16, 0, 0)
#define DA_STAGE(k0, kbf, vbf) do { const bf16* kp_ = B.K + (size_t)(k0) * PITCH; const bf16* vp_ = B.V + (size_t)(k0) * PITCH; \
        _Pragma("unroll") for (int i_ = 0; i_ < 2; ++i_) { const int q_ = wid + 8 * i_; \
            DA_GLDS(kp_ + ksrc[i_], L_K + (kbf) * SHM_K + q_ * 1024); \
            DA_GLDS(vp_ + vsrc[i_], L_V + (vbf) * 32768 + q_ * 1024); DA_GLDS(vp_ + vsrc[i_] + 128, L_V + (vbf) * 32768 + 16384 + q_ * 1024); } } while (0)
#define DA_RESC(a_) do { if (__any((a_) < 1.f)) { \
        _Pragma("unroll") for (int d_ = 0; d_ < 8; ++d_) o[d_] = o[d_] * (a_); } } while (0)
#define DA_PV(vb_) do { pv_half<true>(o, vbase + (vb_) * 32768, pa0, pa1, pa2, pa3); pv_half<true>(o + 4, vbase + (vb_) * 32768 + 16384, pa0, pa1, pa2, pa3); } while (0)
#define DA_PV1(vb_) do { pv_half<false>(o, vbase + (vb_) * 32768, pa0, pa1, pa2, pa3); pv_half<false>(o + 4, vbase + (vb_) * 32768 + 16384, pa0, pa1, pa2, pa3); } while (0)
    __syncthreads();
#define KRD(dst, a_, off) asm volatile("ds_read_b128 %0, %1 offset:%2" : "=&v"(dst) : "v"(a_), "i"(off) : "memory")
#define KMM(x0, x1, d0) do { p0 = __builtin_amdgcn_mfma_f32_32x32x16_bf16(x0, qr[d0], p0, 0, 0, 0); p1 = __builtin_amdgcn_mfma_f32_32x32x16_bf16(x1, qr[d0], p1, 0, 0, 0); } while (0)
#define KW(n) asm volatile("s_waitcnt lgkmcnt(" #n ")" ::: "memory")
#define DA_QK(kbf) do { const int kb0 = (int)(unsigned)(size_t)(Kl + (kbf) * SHM_K); \
            const int ka0 = kb0 + kq, ka1 = kb0 + (kq ^ 32), ka2 = kb0 + (kq ^ 64), ka3 = kb0 + (kq ^ 96);     \
            bf16x8 e0, e1, f0, f1; p0 = f32x16{}; p1 = f32x16{}; \
            KRD(e0, ka0, 0); KRD(e1, ka0, 8192); KRD(f0, ka1, 0); KRD(f1, ka1, 8192); \
            KW(2); SBAR(); KMM(e0, e1, 0); SBAR(); KRD(e0, ka2, 0); KRD(e1, ka2, 8192); \
            KW(2); SBAR(); KMM(f0, f1, 1); SBAR(); KRD(f0, ka3, 0); KRD(f1, ka3, 8192); \
            KW(2); SBAR(); KMM(e0, e1, 2); SBAR(); KRD(e0, ka0, 128); KRD(e1, ka0, 8320); \
            KW(2); SBAR(); KMM(f0, f1, 3); SBAR(); KRD(f0, ka1, 128); KRD(f1, ka1, 8320); \
            KW(2); SBAR(); KMM(e0, e1, 4); SBAR(); KRD(e0, ka2, 128); KRD(e1, ka2, 8320); \
            KW(2); SBAR(); KMM(f0, f1, 5); SBAR(); KRD(f0, ka3, 128); KRD(f1, ka3, 8320); \
            KW(2); SBAR(); KMM(e0, e1, 6); SBAR(); \
            KW(0); SBAR(); KMM(f0, f1, 7); \
            } while (0)
#define PK4(P, B_, OUT) do { unsigned a0 = cvtpk(P[B_+0], P[B_+1]), a1 = cvtpk(P[B_+2], P[B_+3]); unsigned b0 = cvtpk(P[B_+4], P[B_+5]), b1 = cvtpk(P[B_+6], P[B_+7]); \
        auto r0 = __builtin_amdgcn_permlane32_swap(a0, b0, false, false); auto r1 = __builtin_amdgcn_permlane32_swap(a1, b1, false, false); \
        u32x4 w = {r0[0], r1[0], r0[1], r1[1]}; OUT = *reinterpret_cast<bf16x8*>(&w); } while (0)
#define DA_SM(tt) do { const int kfirst = 64 * (tt); \
        if (kfirst + 63 > qlo) { const int dq = qlo + r32 - kfirst - 4 * hi; const float NEG = -__builtin_inff(); \
            _Pragma("unroll") for (int r = 0; r < 16; ++r) { const int c = (r & 3) + 8 * (r >> 2); if (dq - c < 0) p0[r] = NEG; if (dq - c - 32 < 0) p1[r] = NEG; } } \
        float pmax = fmaxf(p0[0], p1[0]); \
        _Pragma("unroll") for (int r = 1; r < 16; ++r) pmax = fmaxf(fmaxf(pmax, p0[r]), p1[r]); \
        { auto rr = __builtin_amdgcn_permlane32_swap(__float_as_uint(pmax), __float_as_uint(pmax), false, false); pmax = fmaxf(__uint_as_float(rr[0]), __uint_as_float(rr[1])); } \
        float mn; \
        if (__builtin_expect(__all((pmax - m_reg) * SCALE <= THR), 1)) { mn = m_reg; alpha = 1.f; } \
        else { mn = fmaxf(m_reg, pmax); alpha = __builtin_amdgcn_exp2f((m_reg - mn) * C2); m_reg = mn; } \
        const float mnL = -mn * C2; float ps = 0.f; \
        p0 = p0 * C2 + mnL; p1 = p1 * C2 + mnL; \
        _Pragma("unroll") for (int r = 0; r < 16; ++r) { p0[r] = __builtin_amdgcn_exp2f(p0[r]); p1[r] = __builtin_amdgcn_exp2f(p1[r]); } \
        _Pragma("unroll") for (int r = 0; r < 16; r += 2) ps += (p0[r] + p1[r]) + (p0[r + 1] + p1[r + 1]); \
        { auto rr = __builtin_amdgcn_permlane32_swap(__float_as_uint(ps), __float_as_uint(ps), false, false); ps = __uint_as_float(rr[0]) + __uint_as_float(rr[1]); } \
        l_reg = l_reg * alpha + ps; \
        PK4(p0, 0, pa0); PK4(p0, 8, pa1); PK4(p1, 0, pa2); PK4(p1, 8, pa3); } while (0)
    DA_STAGE(0, 0, 0);
    float m_reg = -1e30f, l_reg = 0.f, alpha = 1.f; f32x16 o[8] = {};
    bf16x8 pa0 = {}, pa1 = {}, pa2 = {}, pa3 = {};
    f32x16 p0 = {}, p1 = {};
#define DA_BAR(x, vb_next) do { asm volatile("s_waitcnt vmcnt(0)" ::: "memory"); __syncthreads(); if ((x) + 1 < NT) DA_STAGE(64 * ((x) + 1), ((x) + 1) & 1, vb_next); } while (0)
    int vcur = 0;
    if (grpB) __builtin_amdgcn_s_setprio(1);
    for (int t = 0; t < NT; ++t) {
        const int vnext = vcur == 2 ? 0 : vcur + 1, vnn = vnext == 2 ? 0 : vnext + 1;
        if (!grpB || t == 0) DA_BAR(t, vnext);
        DA_QK(t & 1);
        if (grpB && t + 1 < NT) DA_BAR(t + 1, vnn);
        DA_SM(t); DA_RESC(alpha); DA_PV(vcur);
        vcur = vnext;
    }
    __builtin_amdgcn_s_setprio(0);
#undef DA_BAR
#undef DA_QK
#undef DA_SM
#undef KRD
#undef KMM
#undef KW
#undef PK4
#undef DA_STAGE
#undef DA_GLDS
#undef DA_RESC
#undef DA_PV
#undef DA_PV1
    const float inv = __builtin_amdgcn_rcpf(l_reg);
    u32x4* sp = (u32x4*)B.S1 + (size_t)wid * 16 * 64 + lane;
    if (B.mode == 0) {
#pragma unroll
        for (int d0 = 0; d0 < 8; ++d0) {
            unsigned gx[4], gy[4];
#pragma unroll
            for (int k = 0; k < 4; ++k) { gx[k] = cvtpk(o[d0][4 * k] * inv, o[d0][4 * k + 1] * inv); gy[k] = cvtpk(o[d0][4 * k + 2] * inv, o[d0][4 * k + 3] * inv); }
#pragma unroll
            for (int k = 0; k < 4; k += 2) {
                auto rx = __builtin_amdgcn_permlane32_swap(gx[k], gx[k + 1], false, false); auto ry = __builtin_amdgcn_permlane32_swap(gy[k], gy[k + 1], false, false);
                u32x4 w = {rx[0], ry[0], rx[1], ry[1]};
                sp[(d0 * 2 + (k >> 1)) * 64] = w; } }
    } else {
#define DA_CHUNK(d0, k) \
            unsigned gxa = cvtpk(o[d0][4 * (k)] * inv, o[d0][4 * (k) + 1] * inv), gya = cvtpk(o[d0][4 * (k) + 2] * inv, o[d0][4 * (k) + 3] * inv); \
            unsigned gxb = cvtpk(o[d0][4 * (k) + 4] * inv, o[d0][4 * (k) + 5] * inv), gyb = cvtpk(o[d0][4 * (k) + 6] * inv, o[d0][4 * (k) + 7] * inv); \
            auto rx = __builtin_amdgcn_permlane32_swap(gxa, gxb, false, false); auto ry = __builtin_amdgcn_permlane32_swap(gya, gyb, false, false); \
            const u32x4 w2 = {rx[0], ry[0], rx[1], ry[1]}; const u32x4 w1 = sp[((d0) * 2 + ((k) >> 1)) * 64]; float dv[8]; \
            _Pragma("unroll") for (int e = 0; e < 4; ++e) { dv[2 * e] = __uint_as_float(w1[e] << 16) - B.lam * __uint_as_float(w2[e] << 16); dv[2 * e + 1] = __uint_as_float(w1[e] & 0xffff0000u) - B.lam * __uint_as_float(w2[e] & 0xffff0000u); }
        float q = 0.f;
#pragma unroll
        for (int d0 = 0; d0 < 8; ++d0)
#pragma unroll
            for (int k = 0; k < 4; k += 2) { DA_CHUNK(d0, k)
#pragma unroll
                for (int e = 0; e < 8; ++e) q += dv[e] * dv[e]; }
        { auto rr = __builtin_amdgcn_permlane32_swap(__float_as_uint(q), __float_as_uint(q), false, false); q = __uint_as_float(rr[0]) + __uint_as_float(rr[1]); }
        const float rn = (1.0f / sqrtf(q * (1.0f / 256.0f) + 1e-6f)) * 0.8f;
        bf16* mrow = B.MX + (size_t)(32 * pr + r32) * MXP + (hi ? 8 : 0);
        const float* gp = B.gsub + (hi ? 8 : 0);
#pragma unroll
        for (int d0 = 0; d0 < 8; ++d0)
#pragma unroll
            for (int k = 0; k < 4; k += 2) { DA_CHUNK(d0, k)
                const int cb = d0 * 32 + (k >> 1) * 16;
                const f32x4 g0 = *(const f32x4*)(gp + cb), g1 = *(const f32x4*)(gp + cb + 4);
                u32x4 w = {cvtpk(dv[0] * rn * g0[0], dv[1] * rn * g0[1]), cvtpk(dv[2] * rn * g0[2], dv[3] * rn * g0[3]), cvtpk(dv[4] * rn * g1[0], dv[5] * rn * g1[1]), cvtpk(dv[6] * rn * g1[2], dv[7] * rn * g1[3])};
                *(u32x4*)(mrow + cb) = w; }
#undef DA_CHUNK
    }
}
#undef DLAS
}
constexpr int NWAVES = 8;
constexpr int BATCH = 4, SEQ = 4096, DM = 4096, M = BATCH * SEQ;
constexpr int AW = 2048, INW = 12288, DFF = 11008, UPW = 22016, NMOD = 6 * DM;
constexpr float EPS = 1e-6f;
constexpr float LAM_INIT = 0.2f;
constexpr int ADA_KS = 64;
constexpr size_t MiB = 1u << 20;
constexpr size_t WS_CTL = 0, CTL_ZERO_BYTES = 1 * MiB;
constexpr size_t WS_VEC = 1 * MiB;
constexpr size_t WS_SS = 2 * MiB;
constexpr size_t WS_COS = 6 * MiB, WS_SIN = 10 * MiB;
constexpr size_t WS_ADAP = 14 * MiB;
constexpr size_t WS_EDGE = 38 * MiB;
constexpr size_t WS_WIN = 124 * MiB, WS_WOUT = 220 * MiB, WS_WUP = 252 * MiB, WS_WDN = 424 * MiB;
constexpr size_t WS_H = 510 * MiB;
constexpr size_t WS_Y = 638 * MiB;
constexpr size_t WS_X1 = 766 * MiB;
constexpr size_t WS_PROJ = 894 * MiB;
constexpr size_t WS_O = 1278 * MiB;
constexpr size_t WS_G = 894 * MiB;
constexpr size_t WS_END = 1406 * MiB;
static_assert(WS_WIN + (size_t)INW * DM * 2 <= WS_WOUT && WS_WOUT + (size_t)DM * DM * 2 <= WS_WUP && WS_WUP + (size_t)UPW * DM * 2 <= WS_WDN && WS_WDN + (size_t)DM * DFF * 2 <= WS_H, "weights map");
static_assert(WS_EDGE + (size_t)256 * 4 * UPW * 4 <= WS_WIN && WS_ADAP + (size_t)ADA_KS * 4 * NMOD * 4 <= WS_EDGE && WS_H + (size_t)M * DM * 2 <= WS_Y && WS_Y + (size_t)M * DM * 2 <= WS_X1 && WS_X1 + (size_t)M * DM * 2 <= WS_PROJ, "map");
static_assert(WS_PROJ + 6 * (size_t)M * AW * 2 <= WS_O && WS_O + 2 * (size_t)M * AW * 2 <= WS_END && WS_G + (size_t)M * DFF * 2 <= WS_END, "map 2");
constexpr int CW_TMO = 0, CW_CODE = 1, CW_BAR = 4096;
constexpr int RING_OFF = 0, RING_BYTES = 151552;
constexpr int LDSCTL_OFF = RING_BYTES, MISC_OFF = LDSCTL_OFF + 320;
constexpr int LDS_BYTES = 155648;
static_assert(MISC_OFF + 128 <= LDS_BYTES && att::LDS_BYTES <= RING_BYTES && dat::L_END <= RING_BYTES, "LDS map");

#define GAS __attribute__((address_space(1)))
#define LAS __attribute__((address_space(3)))
typedef unsigned short bf16;
typedef unsigned v4u __attribute__((ext_vector_type(4)));
typedef float f32x4 __attribute__((ext_vector_type(4)));
typedef short bf16x8 __attribute__((ext_vector_type(8)));
typedef GAS unsigned gu32;
typedef GAS unsigned long long gu64;
#define RLX_AGENT __ATOMIC_RELAXED, __HIP_MEMORY_SCOPE_AGENT
#define LDS_WAIT() asm volatile("s_waitcnt lgkmcnt(0)" ::: "memory")
#define VM_WAIT() asm volatile("s_waitcnt vmcnt(0)" ::: "memory")
__device__ __forceinline__ unsigned long long rt() { return __builtin_amdgcn_s_memrealtime(); }
__device__ __forceinline__ unsigned f2bf(float f) { unsigned u = __builtin_bit_cast(unsigned, f); return (u + 0x7fffu + ((u >> 16) & 1u)) >> 16; }
typedef float pk2_f32x2 __attribute__((ext_vector_type(2))); typedef __bf16 pk2_bf16x2 __attribute__((ext_vector_type(2)));
__device__ __forceinline__ unsigned pk2(float lo, float hi) { pk2_f32x2 v = {lo, hi}; pk2_bf16x2 b = __builtin_convertvector(v, pk2_bf16x2); return __builtin_bit_cast(unsigned, b); }

#define XB_TMO      128
#define XB_XCNT(j)  (256  + 64 * (j))
#define XB_XSUB(j)  (1280 + 64 * (j))
#define XB_XGEN(j)  (2304 + 64 * (j))
#define XB_TOP      3328
#define XB_TOPGEN   3392
#define XCD_BAR_WORDS 3456
#define XB_SPIN_CAP (1u << 18)

__device__ __forceinline__ unsigned xb_ld(unsigned* p)              { return __hip_atomic_load(p, __ATOMIC_RELAXED, __HIP_MEMORY_SCOPE_AGENT); }
__device__ __forceinline__ unsigned xb_add(unsigned* p, unsigned v) { return __hip_atomic_fetch_add(p, v, __ATOMIC_RELAXED, __HIP_MEMORY_SCOPE_AGENT); }
__device__ __forceinline__ unsigned xb_xcc_id() { return (unsigned)__builtin_amdgcn_s_getreg((3 << 11) | 20) & 0xFu; }
#define XB_SPIN(cond, bar) do { unsigned _sp = 0; while (cond) { __builtin_amdgcn_s_sleep(1); \
    if ((++_sp & 255u) == 0u) { if (xb_ld(&(bar)[XB_TMO])) break; if (_sp > XB_SPIN_CAP) { atomicAdd(&(bar)[XB_TMO], 1u); break; } } } } while (0)

struct XcdBarrier {
    unsigned* bar; unsigned x;
    volatile LAS unsigned* st;
};

__device__ __forceinline__ XcdBarrier xcd_barrier_post(unsigned* bar, volatile LAS unsigned* st) {
    XcdBarrier b; b.bar = bar; b.x = xb_xcc_id(); b.st = st;
    if (threadIdx.x == 0) (void)xb_add(&bar[XB_XCNT(b.x)], 1u);
    return b;
}
__device__ __forceinline__ void xcd_barrier_complete(unsigned* bar, unsigned x, unsigned& nloc, unsigned& nx) {
    const unsigned G = gridDim.x * gridDim.y * gridDim.z;
    unsigned sum, cnt, mine, sp = 0u;
    for (;;) {
        sum = 0u; cnt = 0u; mine = 0u;
#pragma unroll
        for (unsigned j = 0; j < 16; ++j) { const unsigned c = xb_ld(&bar[XB_XCNT(j)]); sum += c; cnt += (c > 0u) ? 1u : 0u; mine = (j == x) ? c : mine; }
        if (sum == G) break;
        __builtin_amdgcn_s_sleep(1);
        if ((++sp & 255u) == 0u) { if (xb_ld(&bar[XB_TMO])) break; if (sp > XB_SPIN_CAP) { atomicAdd(&bar[XB_TMO], 1u); break; } }
    }
    nloc = mine > 0u ? mine : 1u; nx = cnt > 0u ? cnt : 1u;
}

__device__ __forceinline__ void xcd_barrier(const XcdBarrier& b) {
    asm volatile("s_waitcnt vmcnt(0)" ::: "memory");
    __syncthreads();
    if (threadIdx.x == 0) {
        unsigned* bar = b.bar;
        __builtin_amdgcn_s_waitcnt(0);
        unsigned nloc = b.st[0], nx = b.st[1];
        if (nloc == 0u) { xcd_barrier_complete(bar, b.x, nloc, nx); b.st[0] = nloc; b.st[1] = nx; }
        const unsigned old = xb_add(&bar[XB_XSUB(b.x)], 1u);
        const unsigned gen = old / nloc;
        if (old + 1u == (gen + 1u) * nloc) {
            __builtin_amdgcn_fence(__ATOMIC_RELEASE, "agent");
            asm volatile("s_waitcnt vmcnt(0)" ::: "memory");
            const unsigned og = xb_add(&bar[XB_TOP], 1u);
            const unsigned tg = og / nx;
            if (og + 1u == (tg + 1u) * nx) xb_add(&bar[XB_TOPGEN], 1u);
            else XB_SPIN(xb_ld(&bar[XB_TOPGEN]) == tg, bar);
            __builtin_amdgcn_fence(__ATOMIC_ACQUIRE, "agent");
            xb_add(&bar[XB_XGEN(b.x)], 1u);
            asm volatile("s_waitcnt vmcnt(0)" ::: "memory");
        } else {
            XB_SPIN(xb_ld(&bar[XB_XGEN(b.x)]) == gen, bar);
            __builtin_amdgcn_fence(__ATOMIC_ACQUIRE, "agent");
            asm volatile("s_waitcnt vmcnt(0)" ::: "memory");
        }
    }
    __syncthreads();
}
__device__ __forceinline__ float wave_sum(float v) {
#pragma unroll
    for (int o = 1; o < 64; o <<= 1) v += __shfl_xor(v, o);
    return v;
}
__device__ __forceinline__ float bflo(unsigned w) { return __builtin_bit_cast(float, w << 16); }
__device__ __forceinline__ float bfhi(unsigned w) { return __builtin_bit_cast(float, w & 0xffff0000u); }

template <int MODE> __device__ __forceinline__ int wrow_map(int n) {
    if (MODE == 1) { if (n >= 2 * AW) return n; const int d = n & 127; return (n & ~127) + 32 * ((d >> 4) & 3) + 8 * ((d >> 2) & 3) + 4 * (d >> 6) + (d & 3); }
    if (MODE == 2) { const int v = n >= DFF ? 1 : 0, f = n - v * DFF; return (f >> 7) * 256 + v * 128 + (f & 127); }
    return n;
}
typedef float f32x2_t __attribute__((ext_vector_type(2))); typedef __bf16 bf16x2_t __attribute__((ext_vector_type(2)));
__device__ __forceinline__ unsigned cvtpk_rne(float lo, float hi) { f32x2_t v = {lo, hi}; bf16x2_t b = __builtin_convertvector(v, bf16x2_t); return __builtin_bit_cast(unsigned, b); }
template <int MODE> __device__ __forceinline__ void p0_transpose_item(const float* W, int K, int N, bf16* WT, LAS unsigned* scr, int item, int lane) {
    const int nblk = N / 64, kb = item / nblk, nb = item - kb * nblk, k0 = 64 * kb, n0 = 64 * nb;
    const float* src = W + (size_t)k0 * N + n0 + lane;
#pragma unroll 16
    for (int i = 0; i < 32; ++i) { const float a = src[(size_t)(2 * i) * N], b = src[(size_t)(2 * i + 1) * N]; scr[i * 65 + lane] = cvtpk_rne(a, b); }
    LDS_WAIT(); asm volatile("" ::: "memory");
    const int c = lane & 7;
#pragma unroll
    for (int j = 0; j < 8; ++j) { const int n = (lane >> 3) + 8 * j; const LAS unsigned* sp = scr + (4 * c) * 65 + n;
        v4u o; o.x = sp[0]; o.y = sp[65]; o.z = sp[130]; o.w = sp[195];
        *(GAS v4u*)(WT + (size_t)wrow_map<MODE>(n0 + n) * K + k0 + 8 * c) = o; }
    LDS_WAIT(); asm volatile("" ::: "memory");
}

__device__ __forceinline__ void p0_ada_task(const float* cvec, const float* wada, float* part, int task, int lane) {
    const int ec = task % 96, ks = task / 96, e = ec * 256 + lane * 4, dbase = ks * 64;
    float sv[4];
#pragma unroll
    for (int b = 0; b < 4; ++b) { const float c = cvec[b * DM + dbase + lane]; sv[b] = c / (1.0f + __expf(-c)); }
    f32x4 acc[4];
#pragma unroll
    for (int b = 0; b < 4; ++b) acc[b] = (f32x4){0.f, 0.f, 0.f, 0.f};
    const float* wp = wada + (size_t)dbase * NMOD + e;
#pragma unroll 8
    for (int l = 0; l < 64; ++l) {
        const f32x4 w = *(const f32x4*)(wp + (size_t)l * NMOD);
#pragma unroll
        for (int b = 0; b < 4; ++b) { const float s = __builtin_bit_cast(float, __builtin_amdgcn_readlane(__builtin_bit_cast(int, sv[b]), l)); acc[b] = acc[b] + w * s; }
    }
#pragma unroll
    for (int b = 0; b < 4; ++b) *(f32x4*)(part + ((size_t)ks * 4 + b) * NMOD + e) = acc[b];
}

__device__ __forceinline__ void norm_mod_row(const float* xrow, const float* A, const float* SH, bf16* orow, int lane) {
    f32x4 v[8][2]; float s = 0.f;
#pragma unroll
    for (int j = 0; j < 8; ++j)
#pragma unroll
        for (int h = 0; h < 2; ++h) { v[j][h] = *(const f32x4*)(xrow + 512 * j + 8 * lane + 4 * h); s += (v[j][h][0] * v[j][h][0] + v[j][h][1] * v[j][h][1]) + (v[j][h][2] * v[j][h][2] + v[j][h][3] * v[j][h][3]); }
    const float rstd = 1.0f / sqrtf(wave_sum(s) * (1.0f / DM) + EPS);
#pragma unroll
    for (int j = 0; j < 8; ++j) { const int c = 512 * j + 8 * lane;
        const f32x4 a0 = *(const f32x4*)(A + c), a1 = *(const f32x4*)(A + c + 4), s0 = *(const f32x4*)(SH + c), s1 = *(const f32x4*)(SH + c + 4);
        const f32x4 o0 = v[j][0] * rstd * a0 + s0, o1 = v[j][1] * rstd * a1 + s1;
        v4u w; w.x = pk2(o0[0], o0[1]); w.y = pk2(o0[2], o0[3]); w.z = pk2(o1[0], o1[1]); w.w = pk2(o1[2], o1[3]);
        *(GAS v4u*)(orow + c) = w; }
}
struct Args {
    const float* x; const float* c; const int* pos; const float* w_ada; const float* b_ada; const float* g_pre_mix; const float* g_post_mix; const float* w_in;
    const float* lq1; const float* lk1; const float* lq2; const float* lk2; const float* g_subln; const float* w_conv_mix; const float* w_out;
    const float* g_pre_ffn; const float* g_post_ffn; const float* w_up; const float* w_conv_ffn; const float* w_down;
    float* out; unsigned char* ws;
};
constexpr int WGM_P8 = 2;
__global__ void __launch_bounds__(NWAVES * 64, 2) fwd_kernel(Args args) {
    extern __shared__ __attribute__((aligned(16))) unsigned char lds[];
    LAS unsigned char* const ldsb = (LAS unsigned char*)lds;
    volatile LAS unsigned* const MISC = (volatile LAS unsigned*)(ldsb + MISC_OFF);
    const int G = gridDim.x, bx = blockIdx.x, NGW = G * NWAVES, NGT = G * NWAVES * 64;
#define PHASE_IDS() const int tid = opaque_tid(), lane = tid & 63, wave = __builtin_amdgcn_readfirstlane(tid >> 6), gw = bx * NWAVES + wave, gt = bx * (NWAVES * 64) + tid; (void)lane; (void)gw; (void)gt
    unsigned char* const ws = args.ws;
    gu32* const ctl = (gu32*)(ws + WS_CTL);
    float* const VEC = (float*)(ws + WS_VEC);
    float* const SS = (float*)(ws + WS_SS);
    float* const COST = (float*)(ws + WS_COS); float* const SINT = (float*)(ws + WS_SIN);
    float* const ADAP = (float*)(ws + WS_ADAP);
    bf16* const EDGE = (bf16*)(ws + WS_EDGE);
    bf16* const WIN_T = (bf16*)(ws + WS_WIN); bf16* const WOUT_T = (bf16*)(ws + WS_WOUT); bf16* const WUP_T = (bf16*)(ws + WS_WUP); bf16* const WDN_T = (bf16*)(ws + WS_WDN);
    bf16* const HB = (bf16*)(ws + WS_H); bf16* const YB = (bf16*)(ws + WS_Y); bf16* const X1B = (bf16*)(ws + WS_X1);
    bf16* const PROJ = (bf16*)(ws + WS_PROJ); bf16* const OB = (bf16*)(ws + WS_O); bf16* const GB = (bf16*)(ws + WS_G);
    constexpr size_t SEC = (size_t)M * AW;
    bf16* const Qb = PROJ; bf16* const Kb = PROJ + SEC; bf16* const Vb = PROJ + 2 * SEC; bf16* const Bb = PROJ + 3 * SEC; bf16* const Cb = PROJ + 4 * SEC; bf16* const Hcb = PROJ + 5 * SEC;

    for (int u = threadIdx.x; u < (LDS_BYTES - LDSCTL_OFF) / 4; u += NWAVES * 64) ((LAS unsigned*)(ldsb + LDSCTL_OFF))[u] = 0u;
    __syncthreads();
    XcdBarrier bar = xcd_barrier_post((unsigned*)(ctl + CW_BAR), MISC + 8);
#define GRID_BAR() xcd_barrier(bar)

    {
        PHASE_IDS();
        for (int t = gw; t < 96 * ADA_KS; t += NGW) p0_ada_task(args.c, args.w_ada, ADAP, t, lane);
        for (int i = gt; i < M * 64; i += NGT) { const int row = i >> 6, k = i & 63;
            const float inv = (float)pow(10000.0, -(double)k / 64.0); const float ang = (float)args.pos[row] * inv;
            COST[i] = (float)cos((double)ang); SINT[i] = (float)sin((double)ang); }
        LAS unsigned* scr = (LAS unsigned*)(ldsb + RING_OFF + wave * 16384);
        constexpr int I_IN = (DM / 64) * (INW / 64), I_OUT = (DM / 64) * (DM / 64), I_UP = (DM / 64) * (UPW / 64);
        constexpr int NITEMS = I_IN + I_OUT + I_UP;
        for (int it = gw; it < NITEMS; it += NGW) {
            int r = it;
            if (r < I_IN) { p0_transpose_item<1>(args.w_in, DM, INW, WIN_T, scr, r, lane); continue; } r -= I_IN;
            if (r < I_OUT) { p0_transpose_item<0>(args.w_out, DM, DM, WOUT_T, scr, r, lane); continue; } r -= I_OUT;
            p0_transpose_item<2>(args.w_up, DM, UPW, WUP_T, scr, r, lane);
        }
    }
    GRID_BAR();
    { PHASE_IDS();
    for (int i = gt; i < 4 * NMOD; i += NGT) { const int b = i / NMOD, e = i - b * NMOD;
        float pv_[ADA_KS];
#pragma unroll
        for (int ks = 0; ks < ADA_KS; ++ks) pv_[ks] = ADAP[((size_t)ks * 4 + b) * NMOD + e];
#pragma unroll
        for (int w_ = ADA_KS / 2; w_ >= 1; w_ >>= 1)
#pragma unroll
            for (int ks = 0; ks < w_; ++ks) pv_[ks] += pv_[ks + w_];
        float s = pv_[0] + args.b_ada[e];
        const int ch = e >> 12, col = e & 4095; float o;
        if (ch == 0 || ch == 3) o = s;
        else if (ch == 1) o = args.g_pre_mix[col] * (1.0f + s);
        else if (ch == 2) o = s * args.g_post_mix[col];
        else if (ch == 4) o = args.g_pre_ffn[col] * (1.0f + s);
        else o = s * args.g_post_ffn[col];
        VEC[((size_t)ch * 4 + b) * DM + col] = o; } }
    GRID_BAR();
    { PHASE_IDS();
    f32x4 v[8][2], nv[8][2];
    if (gw < M) {
#pragma unroll
        for (int j = 0; j < 8; ++j)
#pragma unroll
            for (int h = 0; h < 2; ++h) nv[j][h] = *(const f32x4*)(args.x + (size_t)gw * DM + 512 * j + 8 * lane + 4 * h); }
    for (int m = gw; m < M; m += NGW) { const int b = m / SEQ;
#pragma unroll
        for (int j = 0; j < 8; ++j)
#pragma unroll
            for (int h = 0; h < 2; ++h) v[j][h] = nv[j][h];
        if (m + NGW < M) {
#pragma unroll
            for (int j = 0; j < 8; ++j)
#pragma unroll
                for (int h = 0; h < 2; ++h) nv[j][h] = *(const f32x4*)(args.x + (size_t)(m + NGW) * DM + 512 * j + 8 * lane + 4 * h); }
        float s = 0.f;
#pragma unroll
        for (int j = 0; j < 8; ++j)
#pragma unroll
            for (int h = 0; h < 2; ++h) s += (v[j][h][0] * v[j][h][0] + v[j][h][1] * v[j][h][1]) + (v[j][h][2] * v[j][h][2] + v[j][h][3] * v[j][h][3]);
        const float rstd = 1.0f / sqrtf(wave_sum(s) * (1.0f / DM) + EPS);
        const float* A = VEC + (size_t)(1 * 4 + b) * DM; const float* SH = VEC + (size_t)(0 * 4 + b) * DM; bf16* orow = HB + (size_t)m * DM;
#pragma unroll
        for (int j = 0; j < 8; ++j) { const int c = 512 * j + 8 * lane;
            const f32x4 a0 = *(const f32x4*)(A + c), a1 = *(const f32x4*)(A + c + 4), s0 = *(const f32x4*)(SH + c), s1 = *(const f32x4*)(SH + c + 4);
            const f32x4 o0 = v[j][0] * rstd * a0 + s0, o1 = v[j][1] * rstd * a1 + s1;
            v4u w; w.x = pk2(o0[0], o0[1]); w.y = pk2(o0[2], o0[3]); w.z = pk2(o1[0], o1[1]); w.w = pk2(o1[2], o1[3]);
            *(GAS v4u*)(orow + c) = w; }
    } }
    GRID_BAR();
    {
        pg8::Gemm g{HB, WIN_T, M, INW, DM}; pg8::StaticOrder S; S.init(M, INW, G, bx);
        pg8::EpiProj E{PROJ, COST, SINT};
        pg8::gemm_phase<pg8::EpiProj, pg8::StaticOrder, true, true>(ldsb + RING_OFF, g, S, E);
    }
    GRID_BAR();
    {
        float lam;
        { PHASE_IDS();
          const float s1 = wave_sum(args.lq1[lane] * args.lk1[lane] + args.lq1[lane + 64] * args.lk1[lane + 64]);
          const float s2 = wave_sum(args.lq2[lane] * args.lk2[lane] + args.lq2[lane + 64] * args.lk2[lane + 64]);
          lam = expf(s1) - expf(s2) + LAM_INIT; }
        for (int L = bx; L < 256; L += G) {
            const int xcd = L & 7, k = L >> 3, sl = k >> 3, x_ = k & 7, bhi = sl * 8 + xcd, b_ = bhi >> 3, h_ = bhi & 7;
            for (int pass = 0; pass < 4; ++pass) { const int j = (pass & 2) ? 15 - x_ : x_, c_ = pass & 1;
                dat::Blk B;
                B.Q = (const att::bf16*)Qb + ((size_t)b_ * SEQ + (size_t)j * dat::QB2) * att::PITCH + h_ * 256 + c_ * 128;
                B.K = (const att::bf16*)Kb + ((size_t)b_ * SEQ) * att::PITCH + h_ * 256 + c_ * 128;
                B.V = (const att::bf16*)Vb + ((size_t)b_ * SEQ) * att::PITCH + h_ * 256;
                B.S1 = (att::bf16*)OB + ((size_t)(bhi * 16 + j)) * 65536;
                B.MX = (att::bf16*)HB + ((size_t)b_ * SEQ + (size_t)j * dat::QB2) * DM + h_ * 256;
                B.gsub = args.g_subln; B.lam = lam; B.j = j; B.mode = c_;
                dat::diff_attn_block(B, ldsb + RING_OFF); }
        }
    }
    GRID_BAR();
    {
        PHASE_IDS();
        for (int task = gw; task < M / 8; task += NGW) {
            const int r0 = task * 8;
            const bool has_prev = (r0 % SEQ) != 0;
#pragma unroll
            for (int i = 0; i < 4; ++i) { const int col = i * 512 + lane * 8;
                float w0[8], w1[8], w2[8];
#pragma unroll
                for (int j = 0; j < 8; ++j) { w0[j] = args.w_conv_mix[col + j]; w1[j] = args.w_conv_mix[AW + col + j]; w2[j] = args.w_conv_mix[2 * AW + col + j]; }
                float p2[8], p1[8];
#pragma unroll
                for (int j = 0; j < 8; ++j) { p2[j] = 0.f; p1[j] = 0.f; }
                if (has_prev) {
                    const v4u c2 = *(const GAS v4u*)(Cb + (size_t)(r0 - 2) * AW + col), h2 = *(const GAS v4u*)(Hcb + (size_t)(r0 - 2) * AW + col);
                    const v4u c1 = *(const GAS v4u*)(Cb + (size_t)(r0 - 1) * AW + col), h1 = *(const GAS v4u*)(Hcb + (size_t)(r0 - 1) * AW + col);
                    p2[0] = bflo(c2.x) * bflo(h2.x); p2[1] = bfhi(c2.x) * bfhi(h2.x); p2[2] = bflo(c2.y) * bflo(h2.y); p2[3] = bfhi(c2.y) * bfhi(h2.y);
                    p2[4] = bflo(c2.z) * bflo(h2.z); p2[5] = bfhi(c2.z) * bfhi(h2.z); p2[6] = bflo(c2.w) * bflo(h2.w); p2[7] = bfhi(c2.w) * bfhi(h2.w);
                    p1[0] = bflo(c1.x) * bflo(h1.x); p1[1] = bfhi(c1.x) * bfhi(h1.x); p1[2] = bflo(c1.y) * bflo(h1.y); p1[3] = bfhi(c1.y) * bfhi(h1.y);
                    p1[4] = bflo(c1.z) * bflo(h1.z); p1[5] = bfhi(c1.z) * bfhi(h1.z); p1[6] = bflo(c1.w) * bflo(h1.w); p1[7] = bfhi(c1.w) * bfhi(h1.w);
                }
                for (int rr = 0; rr < 8; ++rr) { const size_t ro = (size_t)(r0 + rr) * AW + col;
                    const v4u cc = *(const GAS v4u*)(Cb + ro), hh = *(const GAS v4u*)(Hcb + ro), bb = *(const GAS v4u*)(Bb + ro);
                    float p0[8], gb[8], o[8];
                    p0[0] = bflo(cc.x) * bflo(hh.x); p0[1] = bfhi(cc.x) * bfhi(hh.x); p0[2] = bflo(cc.y) * bflo(hh.y); p0[3] = bfhi(cc.y) * bfhi(hh.y);
                    p0[4] = bflo(cc.z) * bflo(hh.z); p0[5] = bfhi(cc.z) * bfhi(hh.z); p0[6] = bflo(cc.w) * bflo(hh.w); p0[7] = bfhi(cc.w) * bfhi(hh.w);
                    gb[0] = bflo(bb.x); gb[1] = bfhi(bb.x); gb[2] = bflo(bb.y); gb[3] = bfhi(bb.y); gb[4] = bflo(bb.z); gb[5] = bfhi(bb.z); gb[6] = bflo(bb.w); gb[7] = bfhi(bb.w);
#pragma unroll
                    for (int j = 0; j < 8; ++j) { o[j] = gb[j] * (w0[j] * p2[j] + w1[j] * p1[j] + w2[j] * p0[j]); p2[j] = p1[j]; p1[j] = p0[j]; }
                    v4u w; w.x = pk2(o[0], o[1]); w.y = pk2(o[2], o[3]); w.z = pk2(o[4], o[5]); w.w = pk2(o[6], o[7]);
                    *(GAS v4u*)(HB + (size_t)(r0 + rr) * DM + AW + col) = w; }
            }
        }
    }
    GRID_BAR();
    {
        pg8::Gemm g{HB, WOUT_T, M, DM, DM}; pg8::StaticOrder S; S.init(M, DM, G, bx);
        pg8::EpiBf16SS E{YB, DM, SS};
        pg8::gemm_phase<pg8::EpiBf16SS, pg8::StaticOrder, true, true>(ldsb + RING_OFF, g, S, E);
    }
    GRID_BAR();
    { PHASE_IDS();
    for (int m = gw; m < M; m += NGW) { const int b = m / SEQ;
        const float ssy = wave_sum(SS[(size_t)m * 64 + lane]);
        const float rsy = 1.0f / sqrtf(ssy * (1.0f / DM) + EPS);
        const float* xr = args.x + (size_t)m * DM; const bf16* yr = YB + (size_t)m * DM; bf16* o1 = X1B + (size_t)m * DM;
        const float* G1 = VEC + (size_t)(2 * 4 + b) * DM; const float* A2 = VEC + (size_t)(4 * 4 + b) * DM; const float* SH2 = VEC + (size_t)(3 * 4 + b) * DM;
        f32x4 v[8][2]; float s = 0.f;
#pragma unroll
        for (int j = 0; j < 8; ++j) { const v4u yw = *(const GAS v4u*)(yr + 512 * j + 8 * lane);
#pragma unroll
            for (int h = 0; h < 2; ++h) { const int c = 512 * j + 8 * lane + 4 * h;
                const f32x4 xv = *(const f32x4*)(xr + c), gv = *(const f32x4*)(G1 + c);
                const f32x4 yv = h == 0 ? (f32x4){bflo(yw.x), bfhi(yw.x), bflo(yw.y), bfhi(yw.y)} : (f32x4){bflo(yw.z), bfhi(yw.z), bflo(yw.w), bfhi(yw.w)};
                const f32x4 x1 = xv + gv * yv * rsy; v[j][h] = x1;
                s += (x1[0] * x1[0] + x1[1] * x1[1]) + (x1[2] * x1[2] + x1[3] * x1[3]); }
            { v4u w; w.x = pk2(v[j][0][0], v[j][0][1]); w.y = pk2(v[j][0][2], v[j][0][3]); w.z = pk2(v[j][1][0], v[j][1][1]); w.w = pk2(v[j][1][2], v[j][1][3]); *(GAS v4u*)(o1 + 512 * j + 8 * lane) = w; } }
        const float rstd = 1.0f / sqrtf(wave_sum(s) * (1.0f / DM) + EPS);
        bf16* orow = HB + (size_t)m * DM;
#pragma unroll
        for (int j = 0; j < 8; ++j) { const int c = 512 * j + 8 * lane;
            const f32x4 a0 = *(const f32x4*)(A2 + c), a1 = *(const f32x4*)(A2 + c + 4), s0 = *(const f32x4*)(SH2 + c), s1 = *(const f32x4*)(SH2 + c + 4);
            const f32x4 q0 = v[j][0] * rstd * a0 + s0, q1 = v[j][1] * rstd * a1 + s1;
            v4u w; w.x = pk2(q0[0], q0[1]); w.y = pk2(q0[2], q0[3]); w.z = pk2(q1[0], q1[1]); w.w = pk2(q1[2], q1[3]);
            *(GAS v4u*)(orow + c) = w; }
    } }
    GRID_BAR();
    {
        pg8::Gemm g{HB, WUP_T, M, UPW, DM}; pg8::StaticOrder S; S.init(M, UPW, G, bx);
        pg8::EpiUp E{GB, args.w_conv_ffn, EDGE};
        pg8::gemm_phase<pg8::EpiUp, pg8::StaticOrder, true, true>(ldsb + RING_OFF, g, S, E);
        {   PHASE_IDS();
            constexpr int I_DN = (DFF / 64) * (DM / 64);
            const int rem = ((M / 256) * (UPW / 256)) % G, nh = rem == 0 ? G : G - rem, hid = rem == 0 ? bx : bx - rem;
            if (hid >= 0) { LAS unsigned* scr = (LAS unsigned*)(ldsb + RING_OFF + wave * 16384);
                for (int it = hid * NWAVES + wave; it < I_DN; it += nh * NWAVES) p0_transpose_item<0>(args.w_down, DFF, DM, WDN_T, scr, it, lane); }
        }
    }
    GRID_BAR();
    { PHASE_IDS();
    for (int i = gt; i < 256 * (DFF / 4); i += NGT) { const int kb = i / (DFF / 4), f = (i - kb * (DFF / 4)) * 4;
        const int cg = (f >> 7) * 256 + (f & 127);
        const bool hp = (kb & 63) != 0;
        const bf16* e = EDGE + (size_t)kb * 4 * UPW;
        const f32x4 z = (f32x4){0.f, 0.f, 0.f, 0.f};
#define LD4BF(p_) ({ const unsigned long long w_ = *(const GAS unsigned long long*)(p_); const unsigned lo_ = (unsigned)w_, hi_ = (unsigned)(w_ >> 32); (f32x4){bflo(lo_), bfhi(lo_), bflo(hi_), bfhi(hi_)}; })
        const f32x4 g0 = hp ? LD4BF(e + cg) : z, g1 = hp ? LD4BF(e + UPW + cg) : z, g2 = LD4BF(e + 2 * UPW + cg), g3 = LD4BF(e + 3 * UPW + cg);
        const f32x4 v0 = hp ? LD4BF(e + cg + 128) : z, v1 = hp ? LD4BF(e + UPW + cg + 128) : z, v2 = LD4BF(e + 2 * UPW + cg + 128), v3 = LD4BF(e + 3 * UPW + cg + 128);
#undef LD4BF
        const float* wc = args.w_conv_ffn;
        const f32x4 wg0 = *(const f32x4*)(wc + f), wg1 = *(const f32x4*)(wc + UPW + f), wg2 = *(const f32x4*)(wc + 2 * UPW + f);
        const f32x4 wv0 = *(const f32x4*)(wc + DFF + f), wv1 = *(const f32x4*)(wc + UPW + DFF + f), wv2 = *(const f32x4*)(wc + 2 * UPW + DFF + f);
        const f32x4 cga = wg0 * g0 + wg1 * g1 + wg2 * g2, cva = wv0 * v0 + wv1 * v1 + wv2 * v2;
        const f32x4 cgb = wg0 * g1 + wg1 * g2 + wg2 * g3, cvb = wv0 * v1 + wv1 * v2 + wv2 * v3;
        float oa[4], ob[4];
#pragma unroll
        for (int j = 0; j < 4; ++j) { oa[j] = pg8::silu_f(cga[j]) * cva[j]; ob[j] = pg8::silu_f(cgb[j]) * cvb[j]; }
        bf16* ga = GB + (size_t)(kb * 64) * DFF + f;
        *(GAS unsigned long long*)ga = (unsigned long long)pk2(oa[0], oa[1]) | ((unsigned long long)pk2(oa[2], oa[3]) << 32);
        *(GAS unsigned long long*)(ga + DFF) = (unsigned long long)pk2(ob[0], ob[1]) | ((unsigned long long)pk2(ob[2], ob[3]) << 32); } }
    GRID_BAR();
    {
        pg8::Gemm g{GB, WDN_T, M, DM, DFF}; pg8::StaticOrder S; S.init(M, DM, G, bx, WGM_P8);
        pg8::EpiBf16SS E{YB, DM, SS};
        pg8::gemm_phase<pg8::EpiBf16SS, pg8::StaticOrder, true, true>(ldsb + RING_OFF, g, S, E);
    }
    GRID_BAR();
    { PHASE_IDS();
    for (int m = gw; m < M; m += NGW) { const int b = m / SEQ;
        const float ssf = wave_sum(SS[(size_t)m * 64 + lane]);
        const float rsf = 1.0f / sqrtf(ssf * (1.0f / DM) + EPS);
        const bf16* fr_ = YB + (size_t)m * DM; const bf16* x1r = X1B + (size_t)m * DM; float* o1 = args.out + (size_t)m * DM; const float* G2 = VEC + (size_t)(5 * 4 + b) * DM;
#pragma unroll
        for (int j = 0; j < 8; ++j) { const v4u fw = *(const GAS v4u*)(fr_ + 512 * j + 8 * lane), xw = *(const GAS v4u*)(x1r + 512 * j + 8 * lane);
#pragma unroll
            for (int h = 0; h < 2; ++h) { const int c = 512 * j + 8 * lane + 4 * h;
                const f32x4 gv = *(const f32x4*)(G2 + c);
                const f32x4 xv = h == 0 ? (f32x4){bflo(xw.x), bfhi(xw.x), bflo(xw.y), bfhi(xw.y)} : (f32x4){bflo(xw.z), bfhi(xw.z), bflo(xw.w), bfhi(xw.w)};
                const f32x4 fv = h == 0 ? (f32x4){bflo(fw.x), bfhi(fw.x), bflo(fw.y), bfhi(fw.y)} : (f32x4){bflo(fw.z), bfhi(fw.z), bflo(fw.w), bfhi(fw.w)};
                *(f32x4*)(o1 + c) = xv + gv * fv * rsf; } }
    } }
}

extern "C" void kernel_launch(void* const* d_in, const int* in_sizes, int n_in, void* d_out, int out_size, void* d_ws, size_t ws_size, hipStream_t stream) {
    static int grid = 0;
    if (grid == 0) {
        if (n_in != 20 || in_sizes[0] != M * DM || out_size != M * DM || ws_size < WS_END) { fprintf(stderr, "kernel_launch: shape/workspace mismatch: n_in %d in0 %d out %d ws %zu (need %zu); nothing launched\n", n_in, n_in > 0 ? in_sizes[0] : -1, out_size, ws_size, (size_t)WS_END); grid = -1; return; }
        int dev = 0, cus = 0, per_cu = 0;
        if (hipGetDevice(&dev) != hipSuccess || hipDeviceGetAttribute(&cus, hipDeviceAttributeMultiprocessorCount, dev) != hipSuccess) { fprintf(stderr, "kernel_launch: device query failed\n"); grid = -1; return; }
        if (hipFuncSetAttribute((const void*)fwd_kernel, hipFuncAttributeMaxDynamicSharedMemorySize, LDS_BYTES) != hipSuccess) { fprintf(stderr, "kernel_launch: hipFuncSetAttribute failed\n"); grid = -1; return; }
        if (hipOccupancyMaxActiveBlocksPerMultiprocessor(&per_cu, (const void*)fwd_kernel, NWAVES * 64, LDS_BYTES) != hipSuccess || per_cu < 1)
            fprintf(stderr, "kernel_launch: note: occupancy query reports %d workgroups per CU\n", per_cu);
        (void)hipGetLastError();
        grid = cus;
    }
    if (grid < 0) return;
    if (hipMemsetAsync((char*)d_ws + WS_CTL, 0, CTL_ZERO_BYTES, stream) != hipSuccess) { fprintf(stderr, "kernel_launch: memset failed\n"); return; }
    Args a{};
    a.x = (const float*)d_in[0]; a.c = (const float*)d_in[1]; a.pos = (const int*)d_in[2]; a.w_ada = (const float*)d_in[3]; a.b_ada = (const float*)d_in[4];
    a.g_pre_mix = (const float*)d_in[5]; a.g_post_mix = (const float*)d_in[6]; a.w_in = (const float*)d_in[7];
    a.lq1 = (const float*)d_in[8]; a.lk1 = (const float*)d_in[9]; a.lq2 = (const float*)d_in[10]; a.lk2 = (const float*)d_in[11];
    a.g_subln = (const float*)d_in[12]; a.w_conv_mix = (const float*)d_in[13]; a.w_out = (const float*)d_in[14];
    a.g_pre_ffn = (const float*)d_in[15]; a.g_post_ffn = (const float*)d_in[16]; a.w_up = (const float*)d_in[17]; a.w_conv_ffn = (const float*)d_in[18]; a.w_down = (const float*)d_in[19];
    a.out = (float*)d_out; a.ws = (unsigned char*)d_ws;
    hipLaunchKernelGGL(fwd_kernel, dim3(grid), dim3(NWAVES * 64), LDS_BYTES, stream, a);
    const hipError_t le = hipPeekAtLastError();
    if (le != hipSuccess) fprintf(stderr, "kernel_launch: launch failed: %s\n", hipGetErrorName(le));
}
```

```cpp
#include <hip/hip_runtime.h>
#include <hip/hip_bf16.h>
#include <cstdio>
#include <cstdint>
__device__ __forceinline__ int opaque_tid() { int t; asm volatile("v_mov_b32 %0, %1" : "=v"(t) : "v"(threadIdx.x)); return t; }
namespace pg8 {
#define PG8_LAS __attribute__((address_space(3)))
typedef unsigned short bf16_t;
typedef short bf16x8 __attribute__((ext_vector_type(8)));
typedef float f32x4 __attribute__((ext_vector_type(4)));
typedef unsigned u32x4 __attribute__((ext_vector_type(4)));
constexpr int BM = 256, BK = 64, HALF = 128, HTB = HALF * BK * 2  , STAGE_BYTES = 8 * HTB, NXCD = 8, WGM = 8;

__host__ __device__ __forceinline__ int lds_byte(int r, int c) { const int st = (r >> 4) * 2 + (c >> 5), rr = r & 15, cc = c & 31, ob = rr * 64 + cc * 2; return st * 1024 + (ob ^ (((ob >> 9) & 1) << 5)); }
__host__ __device__ __forceinline__ void stage_rc(int b, int& R, int& C) { const int st = b / 1024, sb = b % 1024, swz = sb ^ (((sb >> 9) & 1) << 5); R = (st >> 1) * 16 + swz / 64; C = (st & 1) * 32 + (swz % 64) / 2; }
__host__ __device__ __forceinline__ int perm32(int rho) { const int n = rho >> 4, i = rho & 15; return 8 * (i >> 2) + 4 * n + (i & 3); }

struct Unit { int pm, pn; };
struct Gemm { const bf16_t* A; const bf16_t* Bt; int M, N, K; int pa = 0, pb = 0; long ksa = 0, ksb = 0; };

struct StaticOrder {
    int nM, nN, nwg, G, c, wgm;
    __host__ __device__ void init(int M, int N, int G_, int c_, int wgm_ = WGM) { nM = M / BM; nN = N / BM; nwg = nM * nN; G = G_; c = c_; wgm = wgm_; }
    __host__ __device__ bool next(int i, Unit& u) const {
        const long L = (long)i * G + c; if (L >= nwg) return false;
        int wgid = (int)L; { const int q = nwg / NXCD, r = nwg % NXCD, xcd = wgid % NXCD, off = wgid / NXCD; wgid = (xcd < r ? xcd * (q + 1) : r * (q + 1) + (xcd - r) * q) + off; }
        const int nig = wgm * nN, gid = wgid / nig, fm = gid * wgm, gsz = (nM - fm) < wgm ? (nM - fm) : wgm;
        u.pm = fm + ((wgid % nig) % gsz); u.pn = (wgid % nig) / gsz; return true;
    }
    __device__ __forceinline__ void a_ready(const Unit&) const {}
    __device__ __forceinline__ void done(const Unit&) const {}
};

__device__ __forceinline__ unsigned cvt_pk_bf16(float lo, float hi) { unsigned r; asm volatile("v_cvt_pk_bf16_f32 %0, %1, %2" : "=v"(r) : "v"(lo), "v"(hi)); return r; }
typedef float f32x2 __attribute__((ext_vector_type(2)));
constexpr int EP_M = 16384, EP_SECW = 2048, EP_DFF = 11008, EP_UPW = 22016;
constexpr size_t EP_SEC = (size_t)EP_M * EP_SECW;
__device__ __forceinline__ u32x4 pack8(const f32x4 a, const f32x4 b) { u32x4 w; w.x = cvt_pk_bf16(a[0], a[1]); w.y = cvt_pk_bf16(a[2], a[3]); w.z = cvt_pk_bf16(b[0], b[1]); w.w = cvt_pk_bf16(b[2], b[3]); return w; }

struct EpiProj {
    static constexpr bool PERM = true, AFTER_DRAIN = false, AROWS4 = false;
    bf16_t* out; const float* cosT; const float* sinT;
    __device__ __forceinline__ void operator()(const f32x4 (&acc)[2][2][4][2], const Unit& u, int wr, int wc, int fr, int fq) const {
        const int t = u.pn >> 3;
        bf16_t* base = out + (size_t)t * EP_SEC;
        const int row0 = u.pm * BM + wr * 64 + fr, col0 = (u.pn & 7) * BM + wc * 32 + 8 * fq;
        if (t < 2) {
            const int d0 = 16 * wc + 4 * fq;
#pragma unroll
            for (int ai = 0; ai < 2; ++ai)
#pragma unroll
                for (int m = 0; m < 4; ++m) { const int row = row0 + ai * HALF + m * 16;
                    const f32x4 cs = *(const f32x4*)(cosT + (size_t)row * 64 + d0), sn = *(const f32x4*)(sinT + (size_t)row * 64 + d0);
#pragma unroll
                    for (int bj = 0; bj < 2; ++bj) { const f32x4 t0 = acc[ai][bj][m][0], t1 = acc[ai][bj][m][1];
                        const f32x4 lo = t0 * cs - t1 * sn, hi = t1 * cs + t0 * sn;
                        *(u32x4*)(base + (size_t)row * EP_SECW + col0 + bj * HALF) = pack8(lo, hi); } }
        } else if (t >= 4) {
            bf16_t* pb = out + (size_t)4 * EP_SEC + (u.pn - 32) * 128 + wc * 32 + 8 * fq;
#pragma unroll
            for (int ai = 0; ai < 2; ++ai)
#pragma unroll
                for (int m = 0; m < 4; ++m) { const int row = row0 + ai * HALF + m * 16;
                    __builtin_nontemporal_store(pack8(acc[ai][0][m][0] * acc[ai][1][m][0], acc[ai][0][m][1] * acc[ai][1][m][1]), (u32x4*)(pb + (size_t)row * EP_SECW)); }
        } else {
#pragma unroll
            for (int ai = 0; ai < 2; ++ai)
#pragma unroll
                for (int m = 0; m < 4; ++m) { const int row = row0 + ai * HALF + m * 16;
#pragma unroll
                    for (int bj = 0; bj < 2; ++bj) { const u32x4 w_ = pack8(acc[ai][bj][m][0], acc[ai][bj][m][1]); u32x4* p_ = (u32x4*)(base + (size_t)row * EP_SECW + col0 + bj * HALF);
                        if (t == 3) __builtin_nontemporal_store(w_, p_); else *p_ = w_; } }
        }
    }
};

struct EpiF32SS {
    static constexpr bool PERM = false, AFTER_DRAIN = false, AROWS4 = false;
    float* C; int ldc; float* ss;
    __device__ __forceinline__ void operator()(const f32x4 (&acc)[2][2][4][2], const Unit& u, int wr, int wc, int fr, int fq) const {
        const int row0 = u.pm * BM + wr * 64 + fr, col0 = u.pn * BM + wc * 32 + 4 * fq;
#pragma unroll
        for (int ai = 0; ai < 2; ++ai)
#pragma unroll
            for (int m = 0; m < 4; ++m) { const int row = row0 + ai * HALF + m * 16; float* rowp = C + (size_t)row * ldc + col0; float s = 0.f;
#pragma unroll
                for (int bj = 0; bj < 2; ++bj)
#pragma unroll
                    for (int n = 0; n < 2; ++n) { const f32x4 v = acc[ai][bj][m][n]; *(f32x4*)(rowp + bj * HALF + n * 16) = v; s += (v[0] * v[0] + v[1] * v[1]) + (v[2] * v[2] + v[3] * v[3]); }
                s += __shfl_xor(s, 16); s += __shfl_xor(s, 32);
                if (fq == 0) ss[(size_t)row * 64 + u.pn * 4 + wc] = s; }
    }
};

struct EpiBf16SS {
    static constexpr bool PERM = true, AFTER_DRAIN = false, AROWS4 = false;
    bf16_t* C; int ldc; float* ss;
    __device__ __forceinline__ void operator()(const f32x4 (&acc)[2][2][4][2], const Unit& u, int wr, int wc, int fr, int fq) const {
        const int row0 = u.pm * BM + wr * 64 + fr, col0 = u.pn * BM + wc * 32 + 8 * fq;
#pragma unroll
        for (int ai = 0; ai < 2; ++ai)
#pragma unroll
            for (int m = 0; m < 4; ++m) { const int row = row0 + ai * HALF + m * 16; bf16_t* rowp = C + (size_t)row * ldc + col0; float s = 0.f;
#pragma unroll
                for (int bj = 0; bj < 2; ++bj) { const f32x4 v0 = acc[ai][bj][m][0], v1 = acc[ai][bj][m][1];
                    s += ((v0[0] * v0[0] + v0[1] * v0[1]) + (v0[2] * v0[2] + v0[3] * v0[3])) + ((v1[0] * v1[0] + v1[1] * v1[1]) + (v1[2] * v1[2] + v1[3] * v1[3]));
                    *(u32x4*)(rowp + bj * HALF) = pack8(v0, v1); }
                s += __shfl_xor(s, 16); s += __shfl_xor(s, 32);
                if (fq == 0) ss[(size_t)row * 64 + u.pn * 4 + wc] = s; }
    }
};

__device__ __forceinline__ float dpp_shr1(float x) { return __builtin_bit_cast(float, __builtin_amdgcn_update_dpp(0, __builtin_bit_cast(int, x), 0x111, 0xf, 0xf, true)); }
__device__ __forceinline__ float silu_f(float x) { return x * __builtin_amdgcn_rcpf(1.0f + __builtin_amdgcn_exp2f(x * -1.4426950408889634f)); }
struct EpiUp {
    static constexpr bool PERM = true, AFTER_DRAIN = false, AROWS4 = true;
    bf16_t* G; const float* wconv; bf16_t* edge; PG8_LAS unsigned char* xl;
    __device__ __forceinline__ int xslot(int blkt, int wc, int n, int row, int gv, int fq) const { return (((((blkt * 4 + wc) * 2 + n) * 2 + row) * 2 + gv) * 4 + fq) * 16; }
    __device__ __forceinline__ void operator()(const f32x4 (&acc)[2][2][4][2], const Unit& u, int wr, int wc, int fr, int fq) const {
        const int f0 = u.pn * 128 + wc * 32 + 8 * fq;
        const int ce = u.pn * 256 + wc * 32 + 8 * fq;
        if (fr == 15) {
#pragma unroll
            for (int ai = 0; ai < 2; ++ai)
#pragma unroll
                for (int n = 0; n < 2; ++n) { const int bt = ai * 2 + wr;
                    *(PG8_LAS f32x4*)(xl + xslot(bt, wc, n, 0, 0, fq)) = acc[ai][0][2][n]; *(PG8_LAS f32x4*)(xl + xslot(bt, wc, n, 1, 0, fq)) = acc[ai][0][3][n];
                    *(PG8_LAS f32x4*)(xl + xslot(bt, wc, n, 0, 1, fq)) = acc[ai][1][2][n]; *(PG8_LAS f32x4*)(xl + xslot(bt, wc, n, 1, 1, fq)) = acc[ai][1][3][n]; }
        }
        asm volatile("s_waitcnt lgkmcnt(0)" ::: "memory"); __builtin_amdgcn_s_barrier(); asm volatile("" ::: "memory");
        unsigned keep[2][4][2];
#pragma unroll
        for (int n = 0; n < 2; ++n) {
            f32x4 wg[3], wv[3];
#pragma unroll
            for (int j = 0; j < 3; ++j) { wg[j] = *(const f32x4*)(wconv + (size_t)j * EP_UPW + f0 + 4 * n); wv[j] = *(const f32x4*)(wconv + (size_t)j * EP_UPW + EP_DFF + f0 + 4 * n); }
#pragma unroll
            for (int ai = 0; ai < 2; ++ai) {
                const int bt = ai * 2 + wr;
                const f32x4 g0 = acc[ai][0][0][n], g1 = acc[ai][0][1][n], g2 = acc[ai][0][2][n], g3 = acc[ai][0][3][n];
                const f32x4 v0 = acc[ai][1][0][n], v1 = acc[ai][1][1][n], v2 = acc[ai][1][2][n], v3 = acc[ai][1][3][n];
                f32x4 gm1, gm2, vm1, vm2;
#pragma unroll
                for (int j = 0; j < 4; ++j) { gm1[j] = dpp_shr1(g3[j]); gm2[j] = dpp_shr1(g2[j]); vm1[j] = dpp_shr1(v3[j]); vm2[j] = dpp_shr1(v2[j]); }
                if (bt > 0) {
                    const f32x4 lg2 = *(const PG8_LAS f32x4*)(xl + xslot(bt - 1, wc, n, 0, 0, fq)), lg1 = *(const PG8_LAS f32x4*)(xl + xslot(bt - 1, wc, n, 1, 0, fq));
                    const f32x4 lv2 = *(const PG8_LAS f32x4*)(xl + xslot(bt - 1, wc, n, 0, 1, fq)), lv1 = *(const PG8_LAS f32x4*)(xl + xslot(bt - 1, wc, n, 1, 1, fq));
                    if (fr == 0) { gm1 = lg1; gm2 = lg2; vm1 = lv1; vm2 = lv2; }
                }
                const f32x4 cg[4] = { wg[2] * g0 + wg[1] * gm1 + wg[0] * gm2, wg[2] * g1 + wg[1] * g0 + wg[0] * gm1, wg[2] * g2 + wg[1] * g1 + wg[0] * g0, wg[2] * g3 + wg[1] * g2 + wg[0] * g1 };
                const f32x4 cv[4] = { wv[2] * v0 + wv[1] * vm1 + wv[0] * vm2, wv[2] * v1 + wv[1] * v0 + wv[0] * vm1, wv[2] * v2 + wv[1] * v1 + wv[0] * v0, wv[2] * v3 + wv[1] * v2 + wv[0] * v1 };
#pragma unroll
                for (int m = 0; m < 4; ++m) {
                    f32x4 o;
#pragma unroll
                    for (int j = 0; j < 4; ++j) o[j] = silu_f(cg[m][j]) * cv[m][j];
                    const unsigned w0 = cvt_pk_bf16(o[0], o[1]), w1 = cvt_pk_bf16(o[2], o[3]);
                    if (n == 0) { keep[ai][m][0] = w0; keep[ai][m][1] = w1; }
                    else { const int row = u.pm * BM + ai * HALF + wr * 64 + 4 * fr + m;
                        if (fr > 0 || m >= 2 || bt > 0) { u32x4 w; w.x = keep[ai][m][0]; w.y = keep[ai][m][1]; w.z = w0; w.w = w1; __builtin_nontemporal_store(w, (u32x4*)(G + (size_t)(f0 >> 6) * ((size_t)EP_M * 64) + (size_t)row * 64 + (f0 & 63))); } }
                }
#define EDGE_ST(e_, g_, v_) do { *(unsigned long long*)(e_) = (unsigned long long)cvt_pk_bf16(g_[0], g_[1]) | ((unsigned long long)cvt_pk_bf16(g_[2], g_[3]) << 32); \
                        *(unsigned long long*)((e_) + 128) = (unsigned long long)cvt_pk_bf16(v_[0], v_[1]) | ((unsigned long long)cvt_pk_bf16(v_[2], v_[3]) << 32); } while (0)
                if (bt == 0 && fr == 0) { bf16_t* e = edge + ((size_t)(u.pm * 4) * 4 + 2) * EP_UPW + ce + 4 * n; EDGE_ST(e, g0, v0); EDGE_ST(e + EP_UPW, g1, v1); }
                if (bt == 3 && fr == 15 && u.pm * 4 + 4 < 256) { bf16_t* e = edge + ((size_t)(u.pm * 4 + 4) * 4) * EP_UPW + ce + 4 * n; EDGE_ST(e, g2, v2); EDGE_ST(e + EP_UPW, g3, v3); }
#undef EDGE_ST
            }
        }
    }
};

template <class Epi, class Sched, bool ALIGN_EPI = false, bool SP2 = false>
__device__ __forceinline__ void gemm_phase(PG8_LAS unsigned char* lds, const Gemm g, const Sched& S, const Epi& E) {
    const int tid = opaque_tid(), wid = __builtin_amdgcn_readfirstlane(tid >> 6), lane = tid & 63, wr = wid >> 2, wc = wid & 3, fr = lane & 15, fq = lane >> 4;
    const int K = g.K, nt = K / BK;
    const int pA = g.pa ? g.pa : K, pB = g.pb ? g.pb : K;
    unsigned voffA[2], voffB[2];
#pragma unroll
    for (int i = 0; i < 2; ++i) { int R, C; stage_rc(tid * 16 + i * 8192, R, C); const int Rb = Epi::PERM ? ((R & ~31) + perm32(R & 31)) : R;
        const int Ra = Epi::AROWS4 ? ((R & ~63) + 4 * (R & 15) + ((R >> 4) & 3)) : R;
        voffA[i] = (unsigned)(Ra * pA + C) * 2u; voffB[i] = (unsigned)(Rb * pB + C) * 2u; }
    const size_t kstepA = g.ksa ? (size_t)g.ksa : (size_t)(BK * 2), kstepB = g.ksb ? (size_t)g.ksb : (size_t)(BK * 2);
    const size_t hstepA = (size_t)HALF * pA * 2, hstepB = (size_t)HALF * pB * 2;
    const size_t tstepA = 2 * hstepA, tstepB = 2 * hstepB;
    const unsigned ldsw = (unsigned)wid * 1024u;
    const int aoff = lds_byte(wr * 64 + fr, fq * 8), boff = lds_byte(wc * 32 + fr, fq * 8);
#define PG8_SA(b, h) (((b) * 2 + (h)) * HTB)
#define PG8_SB(b, h) ((4 + (b) * 2 + (h)) * HTB)
#define PG8_STAGE(bufoff, gbase, voff) do { _Pragma("unroll") for (int _i = 0; _i < 2; ++_i) \
        __builtin_amdgcn_global_load_lds((const unsigned*)((const char*)(gbase) + (voff)[_i]), (PG8_LAS unsigned*)(lds + (bufoff) + ldsw + _i * 8192), 16, 0, 0); } while (0)
#define PG8_LDA(dst, b, h) do { _Pragma("unroll") for (int m = 0; m < 4; ++m) _Pragma("unroll") for (int k = 0; k < 2; ++k) dst[m][k] = *(const PG8_LAS bf16x8*)(lds + PG8_SA(b, h) + aoff + m * 2048 + k * 1024); } while (0)
#define PG8_LDB(dst, b, h) do { _Pragma("unroll") for (int n = 0; n < 2; ++n) _Pragma("unroll") for (int k = 0; k < 2; ++k) dst[n][k] = *(const PG8_LAS bf16x8*)(lds + PG8_SB(b, h) + boff + n * 2048 + k * 1024); } while (0)
#define PG8_MMA(ai, bj, At, Bt) do { __builtin_amdgcn_s_setprio(1); _Pragma("unroll") for (int m = 0; m < 4; ++m) _Pragma("unroll") for (int n = 0; n < 2; ++n) _Pragma("unroll") for (int k = 0; k < 2; ++k) \
        acc[ai][bj][m][n] = __builtin_amdgcn_mfma_f32_16x16x32_bf16(Bt[n][k], At[m][k], acc[ai][bj][m][n], 0, 0, 0); __builtin_amdgcn_s_setprio(0); } while (0)
#define PG8_WAIT_V(n) asm volatile("s_waitcnt vmcnt(" #n ")" ::: "memory")
#define PG8_WAIT_L(n) asm volatile("s_waitcnt lgkmcnt(" #n ")" ::: "memory")
#define PG8_BAR __builtin_amdgcn_s_barrier()
#define PG8_SCHED __builtin_amdgcn_sched_barrier(0)
    Unit cur, nxt; int ui = 0;
    if (!S.next(0, cur)) return;
    f32x4 acc[2][2][4][2];
#pragma unroll
    for (int a = 0; a < 2; ++a)
#pragma unroll
        for (int b = 0; b < 2; ++b)
#pragma unroll
            for (int m = 0; m < 4; ++m)
#pragma unroll
                for (int n = 0; n < 2; ++n) acc[a][b][m][n] = (f32x4){0.f, 0.f, 0.f, 0.f};
    bf16x8 At[4][2], B0[2][2], B1[2][2];
    const char* cA = (const char*)g.A + (size_t)cur.pm * tstepA; const char* cB = (const char*)g.Bt + (size_t)cur.pn * tstepB;
    S.a_ready(cur);
    if constexpr (SP2) {
        PG8_STAGE(PG8_SB(0, 0), cB, voffB); PG8_STAGE(PG8_SB(0, 1), cB + hstepB, voffB); PG8_STAGE(PG8_SA(0, 0), cA, voffA); PG8_STAGE(PG8_SA(0, 1), cA + hstepA, voffA);
        if (wr == 1) PG8_BAR;
        PG8_WAIT_V(2); PG8_BAR;
        PG8_STAGE(PG8_SB(1, 0), cB + kstepB, voffB); PG8_STAGE(PG8_SA(1, 0), cA + kstepA, voffA); PG8_STAGE(PG8_SB(1, 1), cB + hstepB + kstepB, voffB);
        PG8_WAIT_V(6); PG8_BAR;
    } else {
        PG8_STAGE(PG8_SB(0, 0), cB, voffB); PG8_STAGE(PG8_SA(0, 0), cA, voffA); PG8_STAGE(PG8_SB(0, 1), cB + hstepB, voffB); PG8_STAGE(PG8_SA(0, 1), cA + hstepA, voffA);
        if (wr == 1) PG8_BAR;
        PG8_WAIT_V(4); PG8_BAR;
        PG8_STAGE(PG8_SB(1, 0), cB + kstepB, voffB); PG8_STAGE(PG8_SA(1, 0), cA + kstepA, voffA); PG8_STAGE(PG8_SB(1, 1), cB + hstepB + kstepB, voffB);
        PG8_WAIT_V(6); PG8_BAR;
    }
    for (;;) {
        const bool has_next = S.next(ui + 1, nxt);
        const char* nA = has_next ? (const char*)g.A + (size_t)nxt.pm * tstepA : cA; const char* nB = has_next ? (const char*)g.Bt + (size_t)nxt.pn * tstepB : cB;
        for (int t = 0; t < nt; t += 2) {
            const bool last = (t == nt - 2);
            const char* a1 = cA + (size_t)(t + 1) * kstepA;
            const char* a2 = last ? nA : cA + (size_t)(t + 2) * kstepA; const char* b2 = last ? nB : cB + (size_t)(t + 2) * kstepB;
            const char* a3 = a2 + kstepA; const char* b3 = b2 + kstepB;
            if (last && has_next) S.a_ready(nxt);
            if constexpr (SP2) {
            PG8_LDB(B0, 0, 0); PG8_LDB(B1, 0, 1); PG8_SCHED; PG8_LDA(At, 0, 0); PG8_STAGE(PG8_SA(1, 1), a1 + hstepA, voffA);
            PG8_WAIT_V(8); PG8_WAIT_L(0); PG8_BAR; PG8_MMA(0, 0, At, B0); PG8_MMA(0, 1, At, B1); PG8_BAR; PG8_SCHED;
            PG8_LDA(At, 0, 1); PG8_STAGE(PG8_SB(0, 0), b2, voffB); PG8_STAGE(PG8_SB(0, 1), b2 + hstepB, voffB); PG8_STAGE(PG8_SA(0, 0), a2, voffA);
            PG8_WAIT_V(8); PG8_WAIT_L(0); PG8_BAR; PG8_MMA(1, 0, At, B0); PG8_MMA(1, 1, At, B1); PG8_BAR; PG8_SCHED;
            PG8_LDB(B0, 1, 0); PG8_LDB(B1, 1, 1); PG8_SCHED; PG8_LDA(At, 1, 0); PG8_STAGE(PG8_SA(0, 1), a2 + hstepA, voffA);
            PG8_WAIT_V(8); PG8_WAIT_L(0); PG8_BAR; PG8_MMA(0, 0, At, B0); PG8_MMA(0, 1, At, B1); PG8_BAR; PG8_SCHED;
            PG8_LDA(At, 1, 1); PG8_STAGE(PG8_SB(1, 0), b3, voffB); PG8_STAGE(PG8_SB(1, 1), b3 + hstepB, voffB); PG8_STAGE(PG8_SA(1, 0), a3, voffA);
            PG8_WAIT_V(8); PG8_WAIT_L(0); PG8_BAR; PG8_MMA(1, 0, At, B0); PG8_MMA(1, 1, At, B1); PG8_BAR; PG8_SCHED;
            } else {
            PG8_LDB(B0, 0, 0); PG8_SCHED; PG8_LDA(At, 0, 0); PG8_STAGE(PG8_SA(1, 1), a1 + hstepA, voffA);
            PG8_WAIT_L(8); PG8_BAR; PG8_WAIT_L(0); PG8_MMA(0, 0, At, B0); PG8_BAR; PG8_SCHED;
            PG8_LDB(B1, 0, 1); PG8_STAGE(PG8_SB(0, 0), b2, voffB);
            PG8_BAR; PG8_WAIT_L(0); PG8_MMA(0, 1, At, B1); PG8_BAR;
            PG8_LDA(At, 0, 1); PG8_STAGE(PG8_SA(0, 0), a2, voffA);
            PG8_BAR; PG8_WAIT_L(0); PG8_MMA(1, 0, At, B0); PG8_BAR; PG8_SCHED;
            PG8_STAGE(PG8_SB(0, 1), b2 + hstepB, voffB);
            PG8_WAIT_V(6); PG8_BAR; PG8_MMA(1, 1, At, B1); PG8_BAR;
            PG8_LDB(B0, 1, 0); PG8_SCHED; PG8_LDA(At, 1, 0); PG8_STAGE(PG8_SA(0, 1), a2 + hstepA, voffA);
            PG8_WAIT_L(8); PG8_BAR; PG8_WAIT_L(0); PG8_MMA(0, 0, At, B0); PG8_BAR; PG8_SCHED;
            PG8_LDB(B1, 1, 1); PG8_STAGE(PG8_SB(1, 0), b3, voffB);
            PG8_BAR; PG8_WAIT_L(0); PG8_MMA(0, 1, At, B1); PG8_BAR;
            PG8_LDA(At, 1, 1); PG8_STAGE(PG8_SA(1, 0), a3, voffA);
            PG8_BAR; PG8_WAIT_L(0); PG8_MMA(1, 0, At, B0); PG8_BAR; PG8_SCHED;
            PG8_STAGE(PG8_SB(1, 1), b3 + hstepB, voffB);
            PG8_WAIT_V(6); PG8_BAR; PG8_MMA(1, 1, At, B1); PG8_BAR;
            }
        }
        if constexpr (ALIGN_EPI) { if (wr == 0) PG8_BAR; }
        if constexpr (!Epi::AFTER_DRAIN) { E(acc, cur, wr, wc, fr, fq); S.done(cur); }
        if (!has_next) break;
#pragma unroll
        for (int a = 0; a < 2; ++a)
#pragma unroll
            for (int b = 0; b < 2; ++b)
#pragma unroll
                for (int m = 0; m < 4; ++m)
#pragma unroll
                    for (int n = 0; n < 2; ++n) acc[a][b][m][n] = (f32x4){0.f, 0.f, 0.f, 0.f};
        cur = nxt; cA = nA; cB = nB; ++ui;
        if constexpr (ALIGN_EPI) { if (wr == 1) PG8_BAR; }
    }
    PG8_WAIT_V(0);
    if constexpr (!ALIGN_EPI) { if (wr == 0) PG8_BAR; }
    PG8_BAR;
    if constexpr (Epi::AFTER_DRAIN) { E.fused(acc, cur, wr, wc, fr, fq, lds, wid, lane); S.done(cur); }
#undef PG8_SA
#undef PG8_SB
#undef PG8_STAGE
#undef PG8_LDA
#undef PG8_LDB
#undef PG8_MMA
#undef PG8_WAIT_V
#undef PG8_WAIT_L
#undef PG8_BAR
#undef PG8_SCHED
}
}
namespace att {
enum { ORDER_NATURAL = 0, ORDER_REVERSED = 1, ORDER_PAIRED = 2, ORDER_XCD = 4 };
constexpr int D = 128, PITCH = 2048;
constexpr float THR = 8.f;
constexpr bool WSKIP = false;
constexpr float SCALE = 0.08838834764831845f;
constexpr int NW = 8, QBLK = 32, KVBLK = 64, QB = NW * QBLK;
constexpr int SHM_V = KVBLK * D * 2, SHM_K = KVBLK * D * 2;
constexpr int LDS_BYTES = 2 * SHM_V + 2 * SHM_K + NW * 64 * 4;
using bf16 = __hip_bfloat16;
typedef short bf16x8 __attribute__((ext_vector_type(8)));
typedef short s16x4 __attribute__((ext_vector_type(4)));
typedef float f32x16 __attribute__((ext_vector_type(16)));
typedef float f32x4 __attribute__((ext_vector_type(4)));
typedef unsigned u32x4 __attribute__((ext_vector_type(4)));
template <class A, class Bt> struct same_t { static constexpr bool v = false; };
template <class A> struct same_t<A, A> { static constexpr bool v = true; };

#define KSWZ(row, colB) ((row) * 256 + ((colB) ^ (((row) & 7) << 4)))
#define SBAR() __builtin_amdgcn_sched_barrier(0)
__device__ __forceinline__ int v_st(int k, int c) { const int kk = (k & ~0xC) | ((k & 4) << 1) | ((k & 8) >> 1); return ((kk >> 3) * 4 + (c >> 5)) * 512 + ((kk & 7) * 32 + (c & 31)) * 2; }
__device__ __forceinline__ int v_rd_base(int lane) { return ((lane & 3) << 3) | (((lane >> 2) & 3) << 6) | (((lane >> 4) & 1) << 5) | (((lane >> 5) & 1) << 8); }
constexpr int v_rd_off(int d0, int ks, int half) { return d0 * 512 + ks * 4096 + half * 2048; }
__device__ __forceinline__ int crow(int r, int hi) { return (r & 3) + 8 * (r >> 2) + 4 * hi; }
__device__ __forceinline__ unsigned cvtpk(float lo, float hi) {
    unsigned r; asm volatile("v_cvt_pk_bf16_f32 %0, %1, %2" : "=v"(r) : "v"(lo), "v"(hi)); return r;
}
__device__ __forceinline__ bf16x8 pack8(f32x4 a, f32x4 b) {
    u32x4 w = {cvtpk(a[0], a[1]), cvtpk(a[2], a[3]), cvtpk(b[0], b[1]), cvtpk(b[2], b[3])};
    return *reinterpret_cast<bf16x8*>(&w);
}
template <class T> __device__ __forceinline__ bf16x8 load8(const T* p) {
    if constexpr (same_t<T, float>::v) { return pack8(*(const f32x4*)p, *(const f32x4*)(p + 4)); }
    else { return *reinterpret_cast<const bf16x8*>(p); }
}
__device__ __forceinline__ void mask_tile(f32x16& p0, f32x16& p1, int dq, unsigned W) {
    const float NEG = -__builtin_inff();
#pragma unroll
    for (int r = 0; r < 16; ++r) {
        const int c = (r & 3) + 8 * (r >> 2);
        if ((unsigned)(dq - c) >= W) p0[r] = NEG;
        if ((unsigned)(dq - c - 32) >= W) p1[r] = NEG;
    }
}
__device__ __forceinline__ void partialSM(f32x16& p0, f32x16& p1, float& m_reg, float& mn, float& alpha) {
    float pmax = p0[0]; for (int r = 1; r < 16; ++r) pmax = fmaxf(pmax, p0[r]); for (int r = 0; r < 16; ++r) pmax = fmaxf(pmax, p1[r]);
    { auto rr = __builtin_amdgcn_permlane32_swap(__float_as_uint(pmax), __float_as_uint(pmax), false, false);
      pmax = fmaxf(__uint_as_float(rr[0]), __uint_as_float(rr[1])); }
    constexpr float C2 = 1.4426950408889634f * SCALE;
    if (__builtin_expect(__all((pmax - m_reg) * SCALE <= THR), 1)) { mn = m_reg; alpha = 1.f; }
    else { mn = fmaxf(m_reg, pmax); alpha = __builtin_amdgcn_exp2f((m_reg - mn) * C2); m_reg = mn; }
    const float mnL = -mn * C2;
    for (int r = 0; r < 16; ++r) p0[r] = fmaf(p0[r], C2, mnL); for (int r = 0; r < 16; ++r) p1[r] = fmaf(p1[r], C2, mnL);
    for (int r = 0; r < 16; ++r) p0[r] = __builtin_amdgcn_exp2f(p0[r]);
}
__device__ __forceinline__ void finishSM(f32x16& p0, f32x16& p1, float alpha, float& l_reg, bf16x8& pa0, bf16x8& pa1, bf16x8& pa2, bf16x8& pa3) {
    for (int r = 0; r < 16; ++r) p1[r] = __builtin_amdgcn_exp2f(p1[r]);
    float ps = 0; for (int r = 0; r < 16; ++r) ps += p0[r]; for (int r = 0; r < 16; ++r) ps += p1[r];
    { auto rr = __builtin_amdgcn_permlane32_swap(__float_as_uint(ps), __float_as_uint(ps), false, false);
      ps = __uint_as_float(rr[0]) + __uint_as_float(rr[1]); }
    l_reg = l_reg * alpha + ps;
#define PK4(P, B_, OUT) do { unsigned a0 = cvtpk(P[B_+0], P[B_+1]), a1 = cvtpk(P[B_+2], P[B_+3]);                          \
        unsigned b0 = cvtpk(P[B_+4], P[B_+5]), b1 = cvtpk(P[B_+6], P[B_+7]);                                             \
        auto r0 = __builtin_amdgcn_permlane32_swap(a0, b0, false, false); auto r1 = __builtin_amdgcn_permlane32_swap(a1, b1, false, false); \
        u32x4 w = {r0[0], r1[0], r0[1], r1[1]}; OUT = *reinterpret_cast<bf16x8*>(&w); } while (0)
    PK4(p0, 0, pa0); PK4(p0, 8, pa1); PK4(p1, 0, pa2); PK4(p1, 8, pa3);
#undef PK4
}
template <int KB, bool SK>
__device__ __forceinline__ void qkt(f32x16& p0, f32x16& p1, const char* K_lds, int r32, int hi, const bf16x8* qr, bool act) {
    if (SK && !act) { const float NEG = -__builtin_inff();
#pragma unroll
        for (int r = 0; r < 16; ++r) { p0[r] = NEG; p1[r] = NEG; } return; }
    p0 = f32x16{}; p1 = f32x16{};
    const char* kb[4];
#pragma unroll
    for (int dd = 0; dd < 4; ++dd) kb[dd] = K_lds + KB * SHM_K + KSWZ(r32, (dd * 16 + hi * 8) * 2);
#pragma unroll
    for (int d0 = 0; d0 < 8; ++d0) { const char* a = kb[d0 & 3] + (d0 >> 2) * 128;
        bf16x8 b0 = *reinterpret_cast<const bf16x8*>(a);
        bf16x8 b1 = *reinterpret_cast<const bf16x8*>(a + 32 * 256);
        p0 = __builtin_amdgcn_mfma_f32_32x32x16_bf16(b0, qr[d0], p0, 0, 0, 0);
        p1 = __builtin_amdgcn_mfma_f32_32x32x16_bf16(b1, qr[d0], p1, 0, 0, 0); }
}
template <int VB, bool SK>
__device__ __forceinline__ void pv_tile(f32x16* o, int vb0, bf16x8 pa0, bf16x8 pa1, bf16x8 pa2, bf16x8 pa3, bool act) {
    if (SK && !act) return;
#define TRRD(dst, off) asm volatile("ds_read_b64_tr_b16 %0, %1 offset:%2" : "=&v"(dst) : "v"(vb0), "i"(off) : "memory")
#define PV_D0(d0) do { s16x4 l0, l1, l2, l3, h0, h1, h2, h3; constexpr int b_ = VB * SHM_V + v_rd_off(d0, 0, 0);     \
        TRRD(l0, b_); TRRD(h0, b_ + 2048); TRRD(l1, b_ + 4096); TRRD(h1, b_ + 6144); TRRD(l2, b_ + 8192); TRRD(h2, b_ + 10240); TRRD(l3, b_ + 12288); TRRD(h3, b_ + 14336); \
        asm volatile("s_waitcnt lgkmcnt(0)" ::: "memory"); SBAR();                 \
        o[d0] = __builtin_amdgcn_mfma_f32_32x32x16_bf16(pa0, (bf16x8){l0[0], l0[1], l0[2], l0[3], h0[0], h0[1], h0[2], h0[3]}, o[d0], 0, 0, 0);   \
        o[d0] = __builtin_amdgcn_mfma_f32_32x32x16_bf16(pa1, (bf16x8){l1[0], l1[1], l1[2], l1[3], h1[0], h1[1], h1[2], h1[3]}, o[d0], 0, 0, 0);   \
        o[d0] = __builtin_amdgcn_mfma_f32_32x32x16_bf16(pa2, (bf16x8){l2[0], l2[1], l2[2], l2[3], h2[0], h2[1], h2[2], h2[3]}, o[d0], 0, 0, 0);   \
        o[d0] = __builtin_amdgcn_mfma_f32_32x32x16_bf16(pa3, (bf16x8){l3[0], l3[1], l3[2], l3[3], h3[0], h3[1], h3[2], h3[3]}, o[d0], 0, 0, 0); } while (0)
    PV_D0(0); PV_D0(1); PV_D0(2); PV_D0(3);
#undef PV_D0
#undef TRRD
}

template <class TIn, class TOut> struct BlockRef { const TIn* Q; const TIn* K; const TIn* V; TOut* O; int P0; };
template <class TIn> struct Seam {
    bf16x8 qr[8];
    bf16x8 st_v0, st_v1, st_k0, st_k1; f32x4 sf0, sf1, sf2, sf3;
    f32x4 tq[16];
};
__device__ __forceinline__ int swa_jlo(int P0, int W) { const int lowk = P0 - W + 1; return lowk > 0 ? lowk / KVBLK : 0; }
#define ROW(p, k0, rr) ((p) + (size_t)((k0) + (rr)) * PITCH + sc)
#define VMW() asm volatile("s_waitcnt vmcnt(0)" ::: "memory")
#define VMWN(n) asm volatile("s_waitcnt vmcnt(%0)" :: "i"(n) : "memory")
#define SLOAD_H(Kp, Vp, k0) do { S.st_v0 = load8<TIn>(ROW(Vp, k0, sr)); S.st_v1 = load8<TIn>(ROW(Vp, k0, 32 + sr));              \
                         S.st_k0 = load8<TIn>(ROW(Kp, k0, sr)); S.st_k1 = load8<TIn>(ROW(Kp, k0, 32 + sr)); } while (0)
#define SWRITE_HK(bf) do { *(bf16x8*)(K_lds + (bf) * SHM_K + kws) = S.st_k0; *(bf16x8*)(K_lds + (bf) * SHM_K + kws + 32 * 256) = S.st_k1; } while (0)
#define SWRITE_HV(bf) do { *(bf16x8*)(V_lds + (bf) * SHM_V + vst0) = S.st_v0; *(bf16x8*)(V_lds + (bf) * SHM_V + vst1) = S.st_v1; } while (0)
#define SWRITE_H(bf) do { SWRITE_HV(bf); SWRITE_HK(bf); } while (0)
#define SLOAD_F(p, k0) do { S.sf0 = *(const f32x4*)ROW(p, k0, sr); S.sf1 = *(const f32x4*)(ROW(p, k0, sr) + 4);                \
                            S.sf2 = *(const f32x4*)ROW(p, k0, 32 + sr); S.sf3 = *(const f32x4*)(ROW(p, k0, 32 + sr) + 4); } while (0)
#define SWRITE_KF(bf) do { *(bf16x8*)(K_lds + (bf) * SHM_K + kws) = pack8(S.sf0, S.sf1); *(bf16x8*)(K_lds + (bf) * SHM_K + kws + 32 * 256) = pack8(S.sf2, S.sf3); } while (0)
#define SWRITE_VF(bf) do { *(bf16x8*)(V_lds + (bf) * SHM_V + vst0) = pack8(S.sf0, S.sf1); *(bf16x8*)(V_lds + (bf) * SHM_V + vst1) = pack8(S.sf2, S.sf3); } while (0)
template <class TIn, class TOut>
__device__ __forceinline__ void causal_swa_prime(const BlockRef<TIn, TOut>& cur, int W, char* lds, Seam<TIn>& S) {
    constexpr bool F32 = same_t<TIn, float>::v;
    const int tid = opaque_tid(), wid = __builtin_amdgcn_readfirstlane(tid >> 6), lane = tid & 63, r32 = lane & 31, hi = lane >> 5;
    const int sr = tid >> 4, sc = (tid & 15) * 8, kws = KSWZ(sr, sc * 2); char* K_lds = lds + 2 * SHM_V;
    const int kb0 = swa_jlo(cur.P0, W) * KVBLK;
    for (int d0 = 0; d0 < 8; ++d0) S.qr[d0] = load8<TIn>(cur.Q + (size_t)(wid * QBLK + r32) * PITCH + d0 * 16 + hi * 8);
    if constexpr (F32) { SLOAD_F((const float*)cur.K, kb0); VMW(); SWRITE_KF(0); SBAR(); SLOAD_F((const float*)cur.V, kb0); }
    else { SLOAD_H(cur.K, cur.V, kb0); VMW(); SWRITE_HK(0); }
    __syncthreads();
}
template <class TIn, class TOut>
__device__ __forceinline__ void causal_swa_block(const BlockRef<TIn, TOut>& cur, const BlockRef<TIn, TOut>& nxt, int skv, int W, char* lds, Seam<TIn>& S) {
    constexpr bool F32 = same_t<TIn, float>::v;
    const int tid = opaque_tid(), wid = __builtin_amdgcn_readfirstlane(tid >> 6), lane = tid & 63, r32 = lane & 31, hi = lane >> 5;
    const int j_lo = swa_jlo(cur.P0, W);
    int j_hi = (cur.P0 + QB - 1) / KVBLK + 1; if (j_hi > skv / KVBLK) j_hi = skv / KVBLK;
    const int NT = j_hi - j_lo;
    const int kbn = swa_jlo(nxt.P0, W) * KVBLK;
    const int qlo = cur.P0 + wid * QBLK, qm = qlo + r32 - 4 * hi;
    char* V_lds = lds; char* K_lds = lds + 2 * SHM_V;
    float* ws = (float*)(lds + 2 * SHM_V + 2 * SHM_K) + wid * 64; float* li_l = ws, * al_l = ws + 32;
    float m_reg = -1e30f, l_reg = 0; f32x16 o[4] = {};
    const int sr = tid >> 4, sc = (tid & 15) * 8, vst0 = v_st(sr, sc), vst1 = v_st(32 + sr, sc), kws = KSWZ(sr, sc * 2);
    const int vb0 = (int)(uintptr_t)V_lds + v_rd_base(lane);
    const TIn* Kh = cur.K; const TIn* Vh = cur.V;
#define RESC(a) do { if (__any((a) < 1.f)) { if (hi == 0) al_l[r32] = (a); asm volatile("s_waitcnt lgkmcnt(0)" ::: "memory");              \
                     for (int d_ = 0; d_ < 4; ++d_) for (int r = 0; r < 16; ++r) o[d_][r] *= al_l[crow(r, hi)]; } } while (0)
#define KBASE(t) ((j_lo + (t)) * KVBLK)
#define ACT(t) (KBASE(t) <= qlo + QBLK - 1 && KBASE(t) + KVBLK - 1 >= qlo - W + 1)
#define MASKT(P0_, P1_, t) do { const int kb_ = KBASE(t); if ((!SK || ACT(t)) && (kb_ + KVBLK - 1 > qlo || kb_ <= qlo + QBLK - 1 - W)) mask_tile(P0_, P1_, qm - kb_, (unsigned)W); } while (0)
    constexpr int NQL = F32 ? 16 : 8;
    constexpr bool SK = WSKIP && !F32;
#define SEAM_K0() do { VMWN(NQL); if constexpr (F32) { SWRITE_KF(0); SBAR(); SLOAD_F((const float*)nxt.V, kbn); } else { SWRITE_HK(0); } SBAR(); } while (0)
    f32x16 pA0, pA1, pB0, pB1; float mnA, mnB, alA, alB; bf16x8 pa0, pa1, pa2, pa3;
    if constexpr (F32) { VMW(); SWRITE_VF(0); SBAR(); } else { SWRITE_HV(0); SBAR(); }
    if (NT > 1) { if constexpr (F32) SLOAD_F((const float*)Kh, KBASE(1)); else SLOAD_H(Kh, Vh, KBASE(1)); }
    SBAR(); qkt<0, SK>(pA0, pA1, K_lds, r32, hi, S.qr, ACT(0));
    if constexpr (F32) { if (NT > 1) { VMW(); SWRITE_KF(1); SBAR(); SLOAD_F((const float*)Vh, KBASE(1)); } }
    MASKT(pA0, pA1, 0); partialSM(pA0, pA1, m_reg, mnA, alA);
    if (NT > 1) { VMW(); if constexpr (F32) { SWRITE_VF(1); SBAR(); if (NT > 2) SLOAD_F((const float*)Kh, KBASE(2)); } else SWRITE_H(1); }
    __syncthreads();
#define HALF_STEP(PX0, PX1, mnX, alX, PY0, PY1, alY, t, KB, VB, SB) do {                                                      \
        SBAR(); qkt<KB, SK>(PX0, PX1, K_lds, r32, hi, S.qr, ACT(t));                                             \
        finishSM(PY0, PY1, alY, l_reg, pa0, pa1, pa2, pa3); SBAR();                                                           \
        if ((t) + 1 < NT) { if constexpr (F32) { VMW(); SWRITE_KF(SB); SBAR(); SLOAD_F((const float*)Vh, KBASE((t) + 1)); }  \
                            else { SLOAD_H(Kh, Vh, KBASE((t) + 1)); } SBAR(); }                                               \
        pv_tile<VB, SK>(o, vb0, pa0, pa1, pa2, pa3, ACT((t) - 1)); MASKT(PX0, PX1, (t)); partialSM(PX0, PX1, m_reg, mnX, alX);                                        \
        __syncthreads();                                                                                                      \
        if ((t) + 1 < NT) { VMW(); if constexpr (F32) { SWRITE_VF(SB); SBAR(); if ((t) + 2 < NT) SLOAD_F((const float*)Kh, KBASE((t) + 2)); } \
                            else { SWRITE_H(SB); } }                                                                          \
        RESC(alX); __syncthreads(); } while (0)
    for (int t = 1; t + 1 < NT; t += 2) {
        HALF_STEP(pB0, pB1, mnB, alB, pA0, pA1, alA, t, 1, 0, 0);
        HALF_STEP(pA0, pA1, mnA, alA, pB0, pB1, alB, t + 1, 0, 1, 1);
    }
    const bool even = (NT & 1) == 0;
    if (even) { SBAR(); qkt<1, SK>(pB0, pB1, K_lds, r32, hi, S.qr, ACT(NT - 1)); SBAR(); }
#define QROW(e) (nxt.Q + (size_t)(wid * QBLK + r32) * PITCH + ((e) >> 1) * 16 + hi * 8 + ((e) & 1) * 4)
    if constexpr (F32) { SLOAD_F((const float*)nxt.K, kbn); SBAR();
#pragma unroll
        for (int e = 0; e < 8; ++e) S.tq[e] = *(const f32x4*)QROW(e); }
    else { SLOAD_H(nxt.K, nxt.V, kbn); SBAR();
#pragma unroll
        for (int d0 = 0; d0 < 8; ++d0) S.qr[d0] = load8<TIn>(nxt.Q + (size_t)(wid * QBLK + r32) * PITCH + d0 * 16 + hi * 8); }
    SBAR();
    finishSM(pA0, pA1, alA, l_reg, pa0, pa1, pa2, pa3); SBAR();
    if constexpr (F32) {
#pragma unroll
        for (int e = 8; e < 16; ++e) S.tq[e] = *(const f32x4*)QROW(e); SBAR(); }
#undef QROW
    pv_tile<0, SK>(o, vb0, pa0, pa1, pa2, pa3, ACT(even ? NT - 2 : NT - 1));
    if (even) { MASKT(pB0, pB1, NT - 1); partialSM(pB0, pB1, m_reg, mnB, alB); __syncthreads(); RESC(alB);
        finishSM(pB0, pB1, alB, l_reg, pa0, pa1, pa2, pa3); SBAR(); pv_tile<1, SK>(o, vb0, pa0, pa1, pa2, pa3, ACT(NT - 1)); }
    SBAR(); SEAM_K0();
    if (hi == 0) li_l[r32] = l_reg; asm volatile("s_waitcnt lgkmcnt(0)" ::: "memory");
    float rli[16];
#pragma unroll
    for (int r = 0; r < 16; ++r) rli[r] = __builtin_amdgcn_rcpf(li_l[crow(r, hi)]);
    TOut* Ow = cur.O + (size_t)(wid * QBLK) * PITCH;
#pragma unroll
    for (int r = 0; r < 16; ++r) { const int orow = crow(r, hi);
#pragma unroll
        for (int d0 = 0; d0 < 4; ++d0) { const float v = o[d0][r] * rli[r];
            if constexpr (same_t<TOut, float>::v) { Ow[(size_t)orow * PITCH + d0 * 32 + r32] = v; }
            else { const float vn = __shfl_xor(v, 1);
                   if ((r32 & 1) == 0) *(unsigned*)(Ow + (size_t)orow * PITCH + d0 * 32 + r32) = cvtpk(v, vn); } } }
    if constexpr (F32) {
#pragma unroll
        for (int d0 = 0; d0 < 8; ++d0) S.qr[d0] = pack8(S.tq[2 * d0], S.tq[2 * d0 + 1]); }
    __syncthreads();
#undef RESC
#undef KBASE
#undef ACT
#undef MASKT
#undef SEAM_K0
#undef HALF_STEP
}
#undef ROW
#undef VMW
#undef VMWN
#undef SLOAD_H
#undef SWRITE_HK
#undef SWRITE_HV
#undef SWRITE_H
#undef SLOAD_F
#undef SWRITE_KF
#undef SWRITE_VF

__host__ __device__ inline int swa_nx(int nqb, int nramp, int order) { return (order & ORDER_PAIRED) ? (nramp + 1) / 2 + (nqb - nramp) : nqb; }
struct SwaItem { int bh, qb0, qb1; };
__device__ __forceinline__ SwaItem swa_decode(int L, int nb, int nh, int nhkv, int nqb, int nx, int nramp, int order) {
    const int G = nh / nhkv; SwaItem it; int x;
    if ((order & ORDER_XCD) && (nb * nhkv) % 8 == 0) { const int xcd = L & 7, k = L >> 3, per = G * nx, gi = k / per, r = k - gi * per;
        it.bh = (gi * 8 + xcd) * G + r / nx; x = r % nx; }
    else { it.bh = L / nx; x = L - it.bh * nx; }
    if (order & ORDER_PAIRED) { const int ns = nqb - nramp;
        if (x < ns) { it.qb0 = it.qb1 = nqb - 1 - x; } else { it.qb0 = x - ns; it.qb1 = nramp - 1 - it.qb0; } }
    else { it.qb0 = it.qb1 = ((order & 3) == ORDER_REVERSED) ? nqb - 1 - x : x; }
    return it;
}
}
namespace dat {
using namespace att;
#define DLAS __attribute__((address_space(3)))
constexpr int QB2 = 256;
constexpr int L_K = 0, L_V = 32768, L_AL = 131072, L_END = 133120;
constexpr float C2 = 1.4426950408889634f * SCALE;
struct Blk { const bf16* Q; const bf16* K; const bf16* V; bf16* O; int j; };

template <bool PIPE> __device__ __forceinline__ void pv_half(f32x16* o, int vb0, bf16x8 pa0, bf16x8 pa1, bf16x8 pa2, bf16x8 pa3) {
#define TRRD(dst, off) asm volatile("ds_read_b64_tr_b16 %0, %1 offset:%2" : "=&v"(dst) : "v"(vb0), "i"(off) : "memory")
#define PV_RD(d0, S) do { constexpr int b_ = v_rd_off(d0, 0, 0); TRRD(S##l0, b_); TRRD(S##h0, b_ + 2048); TRRD(S##l1, b_ + 4096); TRRD(S##h1, b_ + 6144); TRRD(S##l2, b_ + 8192); TRRD(S##h2, b_ + 10240); TRRD(S##l3, b_ + 12288); TRRD(S##h3, b_ + 14336); } while (0)
#define PV_MM(d0, S) do { \
        o[d0] = __builtin_amdgcn_mfma_f32_32x32x16_bf16((bf16x8){S##l0[0], S##l0[1], S##l0[2], S##l0[3], S##h0[0], S##h0[1], S##h0[2], S##h0[3]}, pa0, o[d0], 0, 0, 0); \
        o[d0] = __builtin_amdgcn_mfma_f32_32x32x16_bf16((bf16x8){S##l1[0], S##l1[1], S##l1[2], S##l1[3], S##h1[0], S##h1[1], S##h1[2], S##h1[3]}, pa1, o[d0], 0, 0, 0); \
        o[d0] = __builtin_amdgcn_mfma_f32_32x32x16_bf16((bf16x8){S##l2[0], S##l2[1], S##l2[2], S##l2[3], S##h2[0], S##h2[1], S##h2[2], S##h2[3]}, pa2, o[d0], 0, 0, 0); \
        o[d0] = __builtin_amdgcn_mfma_f32_32x32x16_bf16((bf16x8){S##l3[0], S##l3[1], S##l3[2], S##l3[3], S##h3[0], S##h3[1], S##h3[2], S##h3[3]}, pa3, o[d0], 0, 0, 0); } while (0)
    if constexpr (PIPE) {
    s16x4 al0, al1, al2, al3, ah0, ah1, ah2, ah3, bl0, bl1, bl2, bl3, bh0, bh1, bh2, bh3;
    PV_RD(0, a); PV_RD(1, b);
    asm volatile("s_waitcnt lgkmcnt(8)" ::: "memory"); SBAR(); PV_MM(0, a); SBAR();
    PV_RD(2, a);
    asm volatile("s_waitcnt lgkmcnt(8)" ::: "memory"); SBAR(); PV_MM(1, b); SBAR();
    PV_RD(3, b);
    asm volatile("s_waitcnt lgkmcnt(8)" ::: "memory"); SBAR(); PV_MM(2, a); SBAR();
    asm volatile("s_waitcnt lgkmcnt(0)" ::: "memory"); SBAR(); PV_MM(3, b);
    } else {
    s16x4 al0, al1, al2, al3, ah0, ah1, ah2, ah3;
    PV_RD(0, a); asm volatile("s_waitcnt lgkmcnt(0)" ::: "memory"); SBAR(); PV_MM(0, a); SBAR();
    PV_RD(1, a); asm volatile("s_waitcnt lgkmcnt(0)" ::: "memory"); SBAR(); PV_MM(1, a); SBAR();
    PV_RD(2, a); asm volatile("s_waitcnt lgkmcnt(0)" ::: "memory"); SBAR(); PV_MM(2, a); SBAR();
    PV_RD(3, a); asm volatile("s_waitcnt lgkmcnt(0)" ::: "memory"); SBAR(); PV_MM(3, a);
    }
#undef PV_MM
#undef PV_RD
#undef TRRD
}

__device__ __forceinline__ void diff_attn_block(const Blk& B, DLAS unsigned char* lds) {
    const int tid = opaque_tid(), wid = __builtin_amdgcn_readfirstlane(tid >> 6), lane = tid & 63, r32 = lane & 31, hi = lane >> 5;
    const int pr = wid; const bool grpB = wid >= 4;
    const int NT = 4 * (B.j + 1);
    const int qlo = QB2 * B.j + 32 * pr;
    int ksrc[2], vsrc[2];
#pragma unroll
    for (int i = 0; i < 2; ++i) { const int q = wid + 8 * i;
        const int row = 4 * q + (lane >> 4), cs = (lane & 15) ^ (row & 7); ksrc[i] = row * PITCH + cs * 8;
        const int ci = 64 * q + lane, sub = ci >> 5, within = ci & 31, kk = (sub >> 2) * 8 + (within >> 2), key = (kk & ~0xC) | ((kk & 4) << 1) | ((kk & 8) >> 1), c = (sub & 3) * 32 + (within & 3) * 8;
        vsrc[i] = key * PITCH + c; }
    DLAS unsigned char* const Kl = lds + L_K; DLAS unsigned char* const Vl = lds + L_V;
    const int vbase = (int)(unsigned)(size_t)Vl + v_rd_base(lane);
    const int kq = KSWZ(r32, hi * 16);
    bf16x8 qr[8];
#pragma unroll
    for (int d0 = 0; d0 < 8; ++d0) qr[d0] = *reinterpret_cast<const bf16x8*>(B.Q + (size_t)(32 * pr + r32) * PITCH + d0 * 16 + hi * 8);
#define DA_GLDS(gp, ldsoff) __builtin_amdgcn_global_load_lds((const unsigned*)(gp), (DLAS unsigned*)(lds + (ldsoff)), 16, 0, 0)
#define DA_STAGE(k0, kbf, vbf) do { const bf16* kp_ = B.K + (size_t)(k0) * PITCH; const bf16* vp_ = B.V + (size_t)(k0) * PITCH; \
        _Pragma("unroll") for (int i_ = 0; i_ < 2; ++i_) { const int q_ = wid + 8 * i_; \
            DA_GLDS(kp_ + ksrc[i_], L_K + (kbf) * SHM_K + q_ * 1024); \
            DA_GLDS(vp_ + vsrc[i_], L_V + (vbf) * 32768 + q_ * 1024); DA_GLDS(vp_ + vsrc[i_] + 128, L_V + (vbf) * 32768 + 16384 + q_ * 1024); } } while (0)
#define DA_RESC(a_) do { if (__any((a_) < 1.f)) { \
        _Pragma("unroll") for (int d_ = 0; d_ < 8; ++d_) o[d_] = o[d_] * (a_); } } while (0)
#define DA_PV(vb_) do { pv_half<true>(o, vbase + (vb_) * 32768, pa0, pa1, pa2, pa3); pv_half<true>(o + 4, vbase + (vb_) * 32768 + 16384, pa0, pa1, pa2, pa3); } while (0)
#define DA_PV1(vb_) do { pv_half<false>(o, vbase + (vb_) * 32768, pa0, pa1, pa2, pa3); pv_half<false>(o + 4, vbase + (vb_) * 32768 + 16384, pa0, pa1, pa2, pa3); } while (0)
    __syncthreads();
#define KRD(dst, a_, off) asm volatile("ds_read_b128 %0, %1 offset:%2" : "=&v"(dst) : "v"(a_), "i"(off) : "memory")
#define KMM(x0, x1, d0) do { p0 = __builtin_amdgcn_mfma_f32_32x32x16_bf16(x0, qr[d0], p0, 0, 0, 0); p1 = __builtin_amdgcn_mfma_f32_32x32x16_bf16(x1, qr[d0], p1, 0, 0, 0); } while (0)
#define KW(n) asm volatile("s_waitcnt lgkmcnt(" #n ")" ::: "memory")
#define DA_QK(kbf) do { const int kb0 = (int)(unsigned)(size_t)(Kl + (kbf) * SHM_K); \
            const int ka0 = kb0 + kq, ka1 = kb0 + (kq ^ 32), ka2 = kb0 + (kq ^ 64), ka3 = kb0 + (kq ^ 96);     \
            bf16x8 e0, e1, f0, f1; p0 = f32x16{}; p1 = f32x16{}; \
            KRD(e0, ka0, 0); KRD(e1, ka0, 8192); KRD(f0, ka1, 0); KRD(f1, ka1, 8192); \
            KW(2); SBAR(); KMM(e0, e1, 0); SBAR(); KRD(e0, ka2, 0); KRD(e1, ka2, 8192); \
            KW(2); SBAR(); KMM(f0, f1, 1); SBAR(); KRD(f0, ka3, 0); KRD(f1, ka3, 8192); \
            KW(2); SBAR(); KMM(e0, e1, 2); SBAR(); KRD(e0, ka0, 128); KRD(e1, ka0, 8320); \
            KW(2); SBAR(); KMM(f0, f1, 3); SBAR(); KRD(f0, ka1, 128); KRD(f1, ka1, 8320); \
            KW(2); SBAR(); KMM(e0, e1, 4); SBAR(); KRD(e0, ka2, 128); KRD(e1, ka2, 8320); \
            KW(2); SBAR(); KMM(f0, f1, 5); SBAR(); KRD(f0, ka3, 128); KRD(f1, ka3, 8320); \
            KW(2); SBAR(); KMM(e0, e1, 6); SBAR(); \
            KW(0); SBAR(); KMM(f0, f1, 7); \
            } while (0)
#define PK4(P, B_, OUT) do { unsigned a0 = cvtpk(P[B_+0], P[B_+1]), a1 = cvtpk(P[B_+2], P[B_+3]); unsigned b0 = cvtpk(P[B_+4], P[B_+5]), b1 = cvtpk(P[B_+6], P[B_+7]); \
        auto r0 = __builtin_amdgcn_permlane32_swap(a0, b0, false, false); auto r1 = __builtin_amdgcn_permlane32_swap(a1, b1, false, false); \
        u32x4 w = {r0[0], r1[0], r0[1], r1[1]}; OUT = *reinterpret_cast<bf16x8*>(&w); } while (0)
#define DA_SM(tt) do { const int kfirst = 64 * (tt); \
        if (kfirst + 63 > qlo) { const int dq = qlo + r32 - kfirst - 4 * hi; const float NEG = -__builtin_inff(); \
            _Pragma("unroll") for (int r = 0; r < 16; ++r) { const int c = (r & 3) + 8 * (r >> 2); if (dq - c < 0) p0[r] = NEG; if (dq - c - 32 < 0) p1[r] = NEG; } } \
        float pmax = fmaxf(p0[0], p1[0]); \
        _Pragma("unroll") for (int r = 1; r < 16; ++r) pmax = fmaxf(fmaxf(pmax, p0[r]), p1[r]); \
        { auto rr = __builtin_amdgcn_permlane32_swap(__float_as_uint(pmax), __float_as_uint(pmax), false, false); pmax = fmaxf(__uint_as_float(rr[0]), __uint_as_float(rr[1])); } \
        float mn; \
        if (__builtin_expect(__all((pmax - m_reg) * SCALE <= THR), 1)) { mn = m_reg; alpha = 1.f; } \
        else { mn = fmaxf(m_reg, pmax); alpha = __builtin_amdgcn_exp2f((m_reg - mn) * C2); m_reg = mn; } \
        const float mnL = -mn * C2; float ps = 0.f; \
        p0 = p0 * C2 + mnL; p1 = p1 * C2 + mnL; \
        _Pragma("unroll") for (int r = 0; r < 16; ++r) { p0[r] = __builtin_amdgcn_exp2f(p0[r]); p1[r] = __builtin_amdgcn_exp2f(p1[r]); } \
        _Pragma("unroll") for (int r = 0; r < 16; r += 2) ps += (p0[r] + p1[r]) + (p0[r + 1] + p1[r + 1]); \
        { auto rr = __builtin_amdgcn_permlane32_swap(__float_as_uint(ps), __float_as_uint(ps), false, false); ps = __uint_as_float(rr[0]) + __uint_as_float(rr[1]); } \
        l_reg = l_reg * alpha + ps; \
        PK4(p0, 0, pa0); PK4(p0, 8, pa1); PK4(p1, 0, pa2); PK4(p1, 8, pa3); } while (0)
    DA_STAGE(0, 0, 0);
    float m_reg = -1e30f, l_reg = 0.f, alpha = 1.f; f32x16 o[8] = {};
    bf16x8 pa0 = {}, pa1 = {}, pa2 = {}, pa3 = {};
    f32x16 p0 = {}, p1 = {};
#define DA_BAR(x, vb_next) do { asm volatile("s_waitcnt vmcnt(0)" ::: "memory"); __syncthreads(); if ((x) + 1 < NT) DA_STAGE(64 * ((x) + 1), ((x) + 1) & 1, vb_next); } while (0)
    int vcur = 0;
    if (grpB) __builtin_amdgcn_s_setprio(1);
    const int NTact = 4 * B.j + (pr >> 1) + 1;
    for (int t = 0; t < NTact; ++t) {
        const int vnext = vcur == 2 ? 0 : vcur + 1, vnn = vnext == 2 ? 0 : vnext + 1;
        if (!grpB || t == 0) DA_BAR(t, vnext);
        DA_QK(t & 1);
        if (grpB && t + 1 < NT) DA_BAR(t + 1, vnn);
        DA_SM(t); DA_RESC(alpha); DA_PV(vcur);
        vcur = vnext;
    }
    __builtin_amdgcn_s_setprio(0);
    for (int x = grpB ? NTact + 1 : NTact; x < NT; ++x) { const int vb_next = (x + 1) % 3; DA_BAR(x, vb_next); }
#undef DA_BAR
#undef DA_QK
#undef DA_SM
#undef KRD
#undef KMM
#undef KW
#undef PK4
#undef DA_STAGE
#undef DA_GLDS
#undef DA_RESC
#undef DA_PV
#undef DA_PV1
    const float inv = __builtin_amdgcn_rcpf(l_reg);
    bf16* rowp = B.O + (size_t)(32 * pr + r32) * PITCH + (hi ? 8 : 0);
#pragma unroll
    for (int d0 = 0; d0 < 8; ++d0) {
        unsigned gx[4], gy[4];
#pragma unroll
        for (int k = 0; k < 4; ++k) { gx[k] = cvtpk(o[d0][4 * k] * inv, o[d0][4 * k + 1] * inv); gy[k] = cvtpk(o[d0][4 * k + 2] * inv, o[d0][4 * k + 3] * inv); }
#pragma unroll
        for (int k = 0; k < 4; k += 2) {
            auto rx = __builtin_amdgcn_permlane32_swap(gx[k], gx[k + 1], false, false); auto ry = __builtin_amdgcn_permlane32_swap(gy[k], gy[k + 1], false, false);
            u32x4 w = {rx[0], ry[0], rx[1], ry[1]};
            *(u32x4*)(rowp + d0 * 32 + 8 * k) = w; } }
}
#undef DLAS
}
constexpr int NWAVES = 8;
constexpr int BATCH = 4, SEQ = 4096, DM = 4096, M = BATCH * SEQ;
constexpr int AW = 2048, INW = 12288, DFF = 11008, UPW = 22016, NMOD = 6 * DM;
constexpr float EPS = 1e-6f;
constexpr float LAM_INIT = 0.2f;
constexpr int ADA_KS = 64;
constexpr size_t MiB = 1u << 20;
constexpr size_t WS_CTL = 0, CTL_ZERO_BYTES = 32768;
constexpr size_t WS_VEC = 1 * MiB;
constexpr size_t WS_SS = 2 * MiB;
constexpr size_t WS_COS = 6 * MiB, WS_SIN = 10 * MiB;
constexpr size_t WS_ADAP = 14 * MiB;
constexpr size_t WS_EDGE = 38 * MiB;
constexpr size_t WS_WIN = 124 * MiB, WS_WOUT = 220 * MiB, WS_WUP = 252 * MiB, WS_WDN = 424 * MiB;
constexpr size_t WS_H = 510 * MiB;
constexpr size_t WS_Y = 638 * MiB;
constexpr size_t WS_X1 = 766 * MiB;
constexpr size_t WS_PROJ = 894 * MiB;
constexpr size_t WS_O = 1278 * MiB;
constexpr size_t WS_G = 894 * MiB;
constexpr size_t WS_END = 1406 * MiB;
static_assert(WS_WIN + (size_t)INW * DM * 2 <= WS_WOUT && WS_WOUT + (size_t)DM * DM * 2 <= WS_WUP && WS_WUP + (size_t)UPW * DM * 2 <= WS_WDN && WS_WDN + (size_t)DM * DFF * 2 <= WS_H, "weights map");
static_assert(WS_EDGE + (size_t)256 * 4 * UPW * 4 <= WS_WIN && WS_ADAP + (size_t)ADA_KS * 4 * NMOD * 4 <= WS_EDGE && WS_H + (size_t)M * DM * 2 <= WS_Y && WS_Y + (size_t)M * DM * 2 <= WS_X1 && WS_X1 + (size_t)M * DM * 2 <= WS_PROJ, "map");
static_assert(WS_PROJ + 6 * (size_t)M * AW * 2 <= WS_O && WS_O + 2 * (size_t)M * AW * 2 <= WS_END && WS_G + (size_t)M * DFF * 2 <= WS_END, "map 2");
constexpr int CW_TMO = 0, CW_CODE = 1, CW_BAR = 4096;
constexpr int RING_OFF = 0, RING_BYTES = 151552;
constexpr int LDSCTL_OFF = RING_BYTES, MISC_OFF = LDSCTL_OFF + 320;
constexpr int LDS_BYTES = 155648;
static_assert(MISC_OFF + 128 <= LDS_BYTES && att::LDS_BYTES <= RING_BYTES && dat::L_END <= RING_BYTES, "LDS map");

#define GAS __attribute__((address_space(1)))
#define LAS __attribute__((address_space(3)))
typedef unsigned short bf16;
typedef unsigned v4u __attribute__((ext_vector_type(4)));
typedef float f32x4 __attribute__((ext_vector_type(4)));
typedef short bf16x8 __attribute__((ext_vector_type(8)));
typedef GAS unsigned gu32;
typedef GAS unsigned long long gu64;
#define RLX_AGENT __ATOMIC_RELAXED, __HIP_MEMORY_SCOPE_AGENT
#define LDS_WAIT() asm volatile("s_waitcnt lgkmcnt(0)" ::: "memory")
#define VM_WAIT() asm volatile("s_waitcnt vmcnt(0)" ::: "memory")
__device__ __forceinline__ unsigned long long rt() { return __builtin_amdgcn_s_memrealtime(); }
__device__ __forceinline__ unsigned f2bf(float f) { unsigned u = __builtin_bit_cast(unsigned, f); return (u + 0x7fffu + ((u >> 16) & 1u)) >> 16; }
typedef float pk2_f32x2 __attribute__((ext_vector_type(2))); typedef __bf16 pk2_bf16x2 __attribute__((ext_vector_type(2)));
__device__ __forceinline__ unsigned pk2(float lo, float hi) { pk2_f32x2 v = {lo, hi}; pk2_bf16x2 b = __builtin_convertvector(v, pk2_bf16x2); return __builtin_bit_cast(unsigned, b); }

#define XB_TMO      128
#define XB_XCNT(j)  (256  + 64 * (j))
#define XB_XSUB(j)  (1280 + 64 * (j))
#define XB_XGEN(j)  (2304 + 64 * (j))
#define XB_TOP      3328
#define XB_TOPGEN   3392
#define XCD_BAR_WORDS 3456
#define XB_SPIN_CAP (1u << 18)

__device__ __forceinline__ unsigned xb_ld(unsigned* p)              { return __hip_atomic_load(p, __ATOMIC_RELAXED, __HIP_MEMORY_SCOPE_AGENT); }
__device__ __forceinline__ unsigned xb_add(unsigned* p, unsigned v) { return __hip_atomic_fetch_add(p, v, __ATOMIC_RELAXED, __HIP_MEMORY_SCOPE_AGENT); }
__device__ __forceinline__ unsigned xb_xcc_id() { return (unsigned)__builtin_amdgcn_s_getreg((3 << 11) | 20) & 0xFu; }
#define XB_SPIN(cond, bar) do { unsigned _sp = 0; while (cond) { __builtin_amdgcn_s_sleep(1); \
    if ((++_sp & 255u) == 0u) { if (xb_ld(&(bar)[XB_TMO])) break; if (_sp > XB_SPIN_CAP) { atomicAdd(&(bar)[XB_TMO], 1u); break; } } } } while (0)

struct XcdBarrier {
    unsigned* bar; unsigned x;
    volatile LAS unsigned* st;
};

__device__ __forceinline__ XcdBarrier xcd_barrier_post(unsigned* bar, volatile LAS unsigned* st) {
    XcdBarrier b; b.bar = bar; b.x = xb_xcc_id(); b.st = st;
    if (threadIdx.x == 0) (void)xb_add(&bar[XB_XCNT(b.x)], 1u);
    return b;
}
__device__ __forceinline__ void xcd_barrier_complete(unsigned* bar, unsigned x, unsigned& nloc, unsigned& nx) {
    const unsigned G = gridDim.x * gridDim.y * gridDim.z;
    unsigned sum, cnt, mine, sp = 0u;
    for (;;) {
        sum = 0u; cnt = 0u; mine = 0u;
#pragma unroll
        for (unsigned j = 0; j < 16; ++j) { const unsigned c = xb_ld(&bar[XB_XCNT(j)]); sum += c; cnt += (c > 0u) ? 1u : 0u; mine = (j == x) ? c : mine; }
        if (sum == G) break;
        __builtin_amdgcn_s_sleep(1);
        if ((++sp & 255u) == 0u) { if (xb_ld(&bar[XB_TMO])) break; if (sp > XB_SPIN_CAP) { atomicAdd(&bar[XB_TMO], 1u); break; } }
    }
    nloc = mine > 0u ? mine : 1u; nx = cnt > 0u ? cnt : 1u;
}

__device__ __forceinline__ void xcd_barrier(const XcdBarrier& b) {
    asm volatile("s_waitcnt vmcnt(0)" ::: "memory");
    __syncthreads();
    if (threadIdx.x == 0) {
        unsigned* bar = b.bar;
        __builtin_amdgcn_s_waitcnt(0);
        unsigned nloc = b.st[0], nx = b.st[1];
        if (nloc == 0u) { xcd_barrier_complete(bar, b.x, nloc, nx); b.st[0] = nloc; b.st[1] = nx; }
        const unsigned old = xb_add(&bar[XB_XSUB(b.x)], 1u);
        const unsigned gen = old / nloc;
        if (old + 1u == (gen + 1u) * nloc) {
            __builtin_amdgcn_fence(__ATOMIC_RELEASE, "agent");
            asm volatile("s_waitcnt vmcnt(0)" ::: "memory");
            const unsigned og = xb_add(&bar[XB_TOP], 1u);
            const unsigned tg = og / nx;
            if (og + 1u == (tg + 1u) * nx) xb_add(&bar[XB_TOPGEN], 1u);
            else XB_SPIN(xb_ld(&bar[XB_TOPGEN]) == tg, bar);
            __builtin_amdgcn_fence(__ATOMIC_ACQUIRE, "agent");
            xb_add(&bar[XB_XGEN(b.x)], 1u);
            asm volatile("s_waitcnt vmcnt(0)" ::: "memory");
        } else {
            XB_SPIN(xb_ld(&bar[XB_XGEN(b.x)]) == gen, bar);
            __builtin_amdgcn_fence(__ATOMIC_ACQUIRE, "agent");
            asm volatile("s_waitcnt vmcnt(0)" ::: "memory");
        }
    }
    __syncthreads();
}
__device__ __forceinline__ float wave_sum(float v) {
#pragma unroll
    for (int o = 1; o < 64; o <<= 1) v += __shfl_xor(v, o);
    return v;
}
__device__ __forceinline__ float bflo(unsigned w) { return __builtin_bit_cast(float, w << 16); }
__device__ __forceinline__ float bfhi(unsigned w) { return __builtin_bit_cast(float, w & 0xffff0000u); }

template <int MODE> __device__ __forceinline__ int wrow_map(int n) {
    if (MODE == 1) { if (n >= 4 * AW) { const int v = n >= 5 * AW ? 1 : 0, f = n - 4 * AW - v * AW; return 4 * AW + (f >> 7) * 256 + v * 128 + (f & 127); }
        if (n >= 2 * AW) return n; const int d = n & 127; return (n & ~127) + 32 * ((d >> 4) & 3) + 8 * ((d >> 2) & 3) + 4 * (d >> 6) + (d & 3); }
    if (MODE == 2) { const int v = n >= DFF ? 1 : 0, f = n - v * DFF; return (f >> 7) * 256 + v * 128 + (f & 127); }
    return n;
}
typedef float f32x2_t __attribute__((ext_vector_type(2))); typedef __bf16 bf16x2_t __attribute__((ext_vector_type(2)));
__device__ __forceinline__ unsigned cvtpk_rne(float lo, float hi) { f32x2_t v = {lo, hi}; bf16x2_t b = __builtin_convertvector(v, bf16x2_t); return __builtin_bit_cast(unsigned, b); }
template <int MODE, bool KBLK = false> __device__ __forceinline__ void p0_transpose_item(const float* W, int K, int N, bf16* WT, LAS unsigned* scr, int item, int lane) {
    const int nblk = N / 64, kb = item / nblk, nb = item - kb * nblk, k0 = 64 * kb, n0 = 64 * nb;
    const float* src = W + (size_t)k0 * N + n0 + lane;
#pragma unroll 16
    for (int i = 0; i < 32; ++i) { const float a = src[(size_t)(2 * i) * N], b = src[(size_t)(2 * i + 1) * N]; scr[i * 65 + lane] = cvtpk_rne(a, b); }
    LDS_WAIT(); asm volatile("" ::: "memory");
    const int c = lane & 7;
#pragma unroll
    for (int j = 0; j < 8; ++j) { const int n = (lane >> 3) + 8 * j; const LAS unsigned* sp = scr + (4 * c) * 65 + n;
        v4u o; o.x = sp[0]; o.y = sp[65]; o.z = sp[130]; o.w = sp[195];
        if (KBLK) *(GAS v4u*)(WT + (size_t)kb * ((size_t)N * 64) + (size_t)wrow_map<MODE>(n0 + n) * 64 + 8 * c) = o;
        else *(GAS v4u*)(WT + (size_t)wrow_map<MODE>(n0 + n) * K + k0 + 8 * c) = o; }
    LDS_WAIT(); asm volatile("" ::: "memory");
}

__device__ __forceinline__ void p0_ada_task(const float* cvec, const float* wada, float* part, int task, int lane) {
    const int ec = task % 96, ks = task / 96, e = ec * 256 + lane * 4, dbase = ks * 64;
    float sv[4];
#pragma unroll
    for (int b = 0; b < 4; ++b) { const float c = cvec[b * DM + dbase + lane]; sv[b] = c / (1.0f + __expf(-c)); }
    f32x4 acc[4];
#pragma unroll
    for (int b = 0; b < 4; ++b) acc[b] = (f32x4){0.f, 0.f, 0.f, 0.f};
    const float* wp = wada + (size_t)dbase * NMOD + e;
#pragma unroll 8
    for (int l = 0; l < 64; ++l) {
        const f32x4 w = *(const f32x4*)(wp + (size_t)l * NMOD);
#pragma unroll
        for (int b = 0; b < 4; ++b) { const float s = __builtin_bit_cast(float, __builtin_amdgcn_readlane(__builtin_bit_cast(int, sv[b]), l)); acc[b] = acc[b] + w * s; }
    }
#pragma unroll
    for (int b = 0; b < 4; ++b) *(f32x4*)(part + ((size_t)ks * 4 + b) * NMOD + e) = acc[b];
}

__device__ __forceinline__ void norm_mod_row(const float* xrow, const float* A, const float* SH, bf16* orow, int lane) {
    f32x4 v[8][2]; float s = 0.f;
#pragma unroll
    for (int j = 0; j < 8; ++j)
#pragma unroll
        for (int h = 0; h < 2; ++h) { v[j][h] = *(const f32x4*)(xrow + 512 * j + 8 * lane + 4 * h); s += (v[j][h][0] * v[j][h][0] + v[j][h][1] * v[j][h][1]) + (v[j][h][2] * v[j][h][2] + v[j][h][3] * v[j][h][3]); }
    const float rstd = 1.0f / sqrtf(wave_sum(s) * (1.0f / DM) + EPS);
#pragma unroll
    for (int j = 0; j < 8; ++j) { const int c = 512 * j + 8 * lane;
        const f32x4 a0 = *(const f32x4*)(A + c), a1 = *(const f32x4*)(A + c + 4), s0 = *(const f32x4*)(SH + c), s1 = *(const f32x4*)(SH + c + 4);
        const f32x4 o0 = v[j][0] * rstd * a0 + s0, o1 = v[j][1] * rstd * a1 + s1;
        v4u w; w.x = pk2(o0[0], o0[1]); w.y = pk2(o0[2], o0[3]); w.z = pk2(o1[0], o1[1]); w.w = pk2(o1[2], o1[3]);
        *(GAS v4u*)(orow + c) = w; }
}
struct Args {
    const float* x; const float* c; const int* pos; const float* w_ada; const float* b_ada; const float* g_pre_mix; const float* g_post_mix; const float* w_in;
    const float* lq1; const float* lk1; const float* lq2; const float* lk2; const float* g_subln; const float* w_conv_mix; const float* w_out;
    const float* g_pre_ffn; const float* g_post_ffn; const float* w_up; const float* w_conv_ffn; const float* w_down;
    float* out; unsigned char* ws;
};
constexpr int WGM_P8 = 2;
__global__ void __launch_bounds__(NWAVES * 64, 2) fwd_kernel(Args args) {
    extern __shared__ __attribute__((aligned(16))) unsigned char lds[];
    LAS unsigned char* const ldsb = (LAS unsigned char*)lds;
    volatile LAS unsigned* const MISC = (volatile LAS unsigned*)(ldsb + MISC_OFF);
    const int G = gridDim.x, bx = blockIdx.x, NGW = G * NWAVES, NGT = G * NWAVES * 64;
#define PHASE_IDS() const int tid = opaque_tid(), lane = tid & 63, wave = __builtin_amdgcn_readfirstlane(tid >> 6), gw = bx * NWAVES + wave, gt = bx * (NWAVES * 64) + tid; (void)lane; (void)gw; (void)gt
    unsigned char* const ws = args.ws;
    gu32* const ctl = (gu32*)(ws + WS_CTL);
    float* const VEC = (float*)(ws + WS_VEC);
    float* const SS = (float*)(ws + WS_SS);
    float* const COST = (float*)(ws + WS_COS); float* const SINT = (float*)(ws + WS_SIN);
    float* const ADAP = (float*)(ws + WS_ADAP);
    bf16* const EDGE = (bf16*)(ws + WS_EDGE);
    bf16* const WIN_T = (bf16*)(ws + WS_WIN); bf16* const WOUT_T = (bf16*)(ws + WS_WOUT); bf16* const WUP_T = (bf16*)(ws + WS_WUP); bf16* const WDN_T = (bf16*)(ws + WS_WDN);
    bf16* const HB = (bf16*)(ws + WS_H); bf16* const YB = (bf16*)(ws + WS_Y); bf16* const X1B = (bf16*)(ws + WS_X1);
    bf16* const PROJ = (bf16*)(ws + WS_PROJ); bf16* const OB = (bf16*)(ws + WS_O); bf16* const GB = (bf16*)(ws + WS_G);
    constexpr size_t SEC = (size_t)M * AW;
    bf16* const Qb = PROJ; bf16* const Kb = PROJ + SEC; bf16* const Vb = PROJ + 2 * SEC; bf16* const Bb = PROJ + 3 * SEC; bf16* const Cb = PROJ + 4 * SEC; bf16* const Hcb = PROJ + 5 * SEC;

    for (int u = threadIdx.x; u < (LDS_BYTES - LDSCTL_OFF) / 4; u += NWAVES * 64) ((LAS unsigned*)(ldsb + LDSCTL_OFF))[u] = 0u;
    __syncthreads();
    XcdBarrier bar = xcd_barrier_post((unsigned*)(ctl + CW_BAR), MISC + 8);
#define GRID_BAR() xcd_barrier(bar)

    {
        PHASE_IDS();
        for (int t = gw; t < 96 * ADA_KS; t += NGW) p0_ada_task(args.c, args.w_ada, ADAP, t, lane);
        for (int i = gt; i < M * 64; i += NGT) { const int row = i >> 6, k = i & 63;
            const float inv = (float)pow(10000.0, -(double)k / 64.0); const float ang = (float)args.pos[row] * inv;
            COST[i] = (float)cos((double)ang); SINT[i] = (float)sin((double)ang); }
        LAS unsigned* scr = (LAS unsigned*)(ldsb + RING_OFF + wave * 16384);
        constexpr int I_IN = (DM / 64) * (INW / 64), I_OUT = (DM / 64) * (DM / 64), I_UP = (DM / 64) * (UPW / 64);
        constexpr int NITEMS = I_IN + I_OUT + I_UP;
        for (int it = gw; it < NITEMS; it += NGW) {
            int r = it;
            if (r < I_IN) { p0_transpose_item<1>(args.w_in, DM, INW, WIN_T, scr, r, lane); continue; } r -= I_IN;
            if (r < I_OUT) { p0_transpose_item<0>(args.w_out, DM, DM, WOUT_T, scr, r, lane); continue; } r -= I_OUT;
            p0_transpose_item<2>(args.w_up, DM, UPW, WUP_T, scr, r, lane);
        }
    }
    GRID_BAR();
    { PHASE_IDS();
    for (int i = gt; i < 4 * NMOD; i += NGT) { const int b = i / NMOD, e = i - b * NMOD;
        float pv_[ADA_KS];
#pragma unroll
        for (int ks = 0; ks < ADA_KS; ++ks) pv_[ks] = ADAP[((size_t)ks * 4 + b) * NMOD + e];
#pragma unroll
        for (int w_ = ADA_KS / 2; w_ >= 1; w_ >>= 1)
#pragma unroll
            for (int ks = 0; ks < w_; ++ks) pv_[ks] += pv_[ks + w_];
        float s = pv_[0] + args.b_ada[e];
        const int ch = e >> 12, col = e & 4095; float o;
        if (ch == 0 || ch == 3) o = s;
        else if (ch == 1) o = args.g_pre_mix[col] * (1.0f + s);
        else if (ch == 2) o = s * args.g_post_mix[col];
        else if (ch == 4) o = args.g_pre_ffn[col] * (1.0f + s);
        else o = s * args.g_post_ffn[col];
        VEC[((size_t)ch * 4 + b) * DM + col] = o; } }
    GRID_BAR();
    { PHASE_IDS();
    f32x4 v[8][2], nv[8][2];
    if (gw < M) {
#pragma unroll
        for (int j = 0; j < 8; ++j)
#pragma unroll
            for (int h = 0; h < 2; ++h) nv[j][h] = *(const f32x4*)(args.x + (size_t)gw * DM + 512 * j + 8 * lane + 4 * h); }
    for (int m = gw; m < M; m += NGW) { const int b = m / SEQ;
#pragma unroll
        for (int j = 0; j < 8; ++j)
#pragma unroll
            for (int h = 0; h < 2; ++h) v[j][h] = nv[j][h];
        if (m + NGW < M) {
#pragma unroll
            for (int j = 0; j < 8; ++j)
#pragma unroll
                for (int h = 0; h < 2; ++h) nv[j][h] = *(const f32x4*)(args.x + (size_t)(m + NGW) * DM + 512 * j + 8 * lane + 4 * h); }
        float s = 0.f;
#pragma unroll
        for (int j = 0; j < 8; ++j)
#pragma unroll
            for (int h = 0; h < 2; ++h) s += (v[j][h][0] * v[j][h][0] + v[j][h][1] * v[j][h][1]) + (v[j][h][2] * v[j][h][2] + v[j][h][3] * v[j][h][3]);
        const float rstd = 1.0f / sqrtf(wave_sum(s) * (1.0f / DM) + EPS);
        const float* A = VEC + (size_t)(1 * 4 + b) * DM; const float* SH = VEC + (size_t)(0 * 4 + b) * DM; bf16* orow = HB + (size_t)m * DM;
#pragma unroll
        for (int j = 0; j < 8; ++j) { const int c = 512 * j + 8 * lane;
            const f32x4 a0 = *(const f32x4*)(A + c), a1 = *(const f32x4*)(A + c + 4), s0 = *(const f32x4*)(SH + c), s1 = *(const f32x4*)(SH + c + 4);
            const f32x4 o0 = v[j][0] * rstd * a0 + s0, o1 = v[j][1] * rstd * a1 + s1;
            v4u w; w.x = pk2(o0[0], o0[1]); w.y = pk2(o0[2], o0[3]); w.z = pk2(o1[0], o1[1]); w.w = pk2(o1[2], o1[3]);
            *(GAS v4u*)(orow + c) = w; }
    } }
    GRID_BAR();
    {
        pg8::Gemm g{HB, WIN_T, M, INW, DM}; pg8::StaticOrder S; S.init(M, INW, G, bx);
        pg8::EpiProj E{PROJ, COST, SINT};
        pg8::gemm_phase<pg8::EpiProj, pg8::StaticOrder, true, true>(ldsb + RING_OFF, g, S, E);
    }
    GRID_BAR();
    {
        for (int L = bx; L < 512; L += G) {
            const int xcd = L & 7, k = L >> 3, sl = k >> 4, r = k & 15, bhi = sl * 8 + xcd, b_ = bhi >> 3, h_ = bhi & 7, c_ = r >> 3, x_ = r & 7;
            for (int pass = 0; pass < 2; ++pass) { const int j = pass ? 15 - x_ : x_;
                dat::Blk B;
                B.Q = (const att::bf16*)Qb + ((size_t)b_ * SEQ + (size_t)j * dat::QB2) * att::PITCH + h_ * 256 + c_ * 128;
                B.K = (const att::bf16*)Kb + ((size_t)b_ * SEQ) * att::PITCH + h_ * 256 + c_ * 128;
                B.V = (const att::bf16*)Vb + ((size_t)b_ * SEQ) * att::PITCH + h_ * 256;
                B.O = (att::bf16*)OB + (size_t)c_ * SEC + ((size_t)b_ * SEQ + (size_t)j * dat::QB2) * att::PITCH + h_ * 256; B.j = j;
                dat::diff_attn_block(B, ldsb + RING_OFF); }
        }
    }
    GRID_BAR();
    {
        PHASE_IDS();
        const float s1 = wave_sum(args.lq1[lane] * args.lk1[lane] + args.lq1[lane + 64] * args.lk1[lane + 64]);
        const float s2 = wave_sum(args.lq2[lane] * args.lk2[lane] + args.lq2[lane + 64] * args.lk2[lane + 64]);
        const float lam = expf(s1) - expf(s2) + LAM_INIT;
        const f32x4 gs0 = *(const f32x4*)(args.g_subln + (lane & 31) * 8), gs1 = *(const f32x4*)(args.g_subln + (lane & 31) * 8 + 4);
        const bf16* O1 = OB; const bf16* O2 = OB + SEC;
        for (int task = gw; task < M / 8; task += NGW) {
            const int r0 = task * 8;
            for (int rr = 0; rr < 8; ++rr) { const size_t rowoff = (size_t)(r0 + rr) * AW;
#pragma unroll
                for (int i = 0; i < 4; ++i) { const int col = i * 512 + lane * 8;
                    const v4u a = *(const GAS v4u*)(O1 + rowoff + col), b2 = *(const GAS v4u*)(O2 + rowoff + col);
                    float o[8];
                    o[0] = bflo(a.x) - lam * bflo(b2.x); o[1] = bfhi(a.x) - lam * bfhi(b2.x); o[2] = bflo(a.y) - lam * bflo(b2.y); o[3] = bfhi(a.y) - lam * bfhi(b2.y);
                    o[4] = bflo(a.z) - lam * bflo(b2.z); o[5] = bfhi(a.z) - lam * bfhi(b2.z); o[6] = bflo(a.w) - lam * bflo(b2.w); o[7] = bfhi(a.w) - lam * bfhi(b2.w);
                    float q = 0.f;
#pragma unroll
                    for (int j = 0; j < 8; ++j) q += o[j] * o[j];
#pragma unroll
                    for (int sft = 1; sft < 32; sft <<= 1) q += __shfl_xor(q, sft);
                    const float r = (1.0f / sqrtf(q * (1.0f / 256.0f) + EPS)) * (1.0f - LAM_INIT);
                    v4u w; w.x = pk2(o[0] * r * gs0[0], o[1] * r * gs0[1]); w.y = pk2(o[2] * r * gs0[2], o[3] * r * gs0[3]); w.z = pk2(o[4] * r * gs1[0], o[5] * r * gs1[1]); w.w = pk2(o[6] * r * gs1[2], o[7] * r * gs1[3]);
                    *(GAS v4u*)(HB + (size_t)(r0 + rr) * DM + col) = w; } }
            const bool has_prev = (r0 % SEQ) != 0;
#pragma unroll
            for (int i = 0; i < 4; ++i) { const int col = i * 512 + lane * 8;
                float w0[8], w1[8], w2[8];
#pragma unroll
                for (int j = 0; j < 8; ++j) { w0[j] = args.w_conv_mix[col + j]; w1[j] = args.w_conv_mix[AW + col + j]; w2[j] = args.w_conv_mix[2 * AW + col + j]; }
                float p2[8], p1[8];
#pragma unroll
                for (int j = 0; j < 8; ++j) { p2[j] = 0.f; p1[j] = 0.f; }
                if (has_prev) {
                    const v4u q2 = *(const GAS v4u*)(Cb + (size_t)(r0 - 2) * AW + col), q1 = *(const GAS v4u*)(Cb + (size_t)(r0 - 1) * AW + col);
                    p2[0] = bflo(q2.x); p2[1] = bfhi(q2.x); p2[2] = bflo(q2.y); p2[3] = bfhi(q2.y); p2[4] = bflo(q2.z); p2[5] = bfhi(q2.z); p2[6] = bflo(q2.w); p2[7] = bfhi(q2.w);
                    p1[0] = bflo(q1.x); p1[1] = bfhi(q1.x); p1[2] = bflo(q1.y); p1[3] = bfhi(q1.y); p1[4] = bflo(q1.z); p1[5] = bfhi(q1.z); p1[6] = bflo(q1.w); p1[7] = bfhi(q1.w);
                }
                for (int rr = 0; rr < 8; ++rr) { const size_t ro = (size_t)(r0 + rr) * AW + col;
                    const v4u cc = *(const GAS v4u*)(Cb + ro), bb = *(const GAS v4u*)(Bb + ro);
                    float p0[8], gb[8], o[8];
                    p0[0] = bflo(cc.x); p0[1] = bfhi(cc.x); p0[2] = bflo(cc.y); p0[3] = bfhi(cc.y); p0[4] = bflo(cc.z); p0[5] = bfhi(cc.z); p0[6] = bflo(cc.w); p0[7] = bfhi(cc.w);
                    gb[0] = bflo(bb.x); gb[1] = bfhi(bb.x); gb[2] = bflo(bb.y); gb[3] = bfhi(bb.y); gb[4] = bflo(bb.z); gb[5] = bfhi(bb.z); gb[6] = bflo(bb.w); gb[7] = bfhi(bb.w);
#pragma unroll
                    for (int j = 0; j < 8; ++j) { o[j] = gb[j] * (w0[j] * p2[j] + w1[j] * p1[j] + w2[j] * p0[j]); p2[j] = p1[j]; p1[j] = p0[j]; }
                    v4u w; w.x = pk2(o[0], o[1]); w.y = pk2(o[2], o[3]); w.z = pk2(o[4], o[5]); w.w = pk2(o[6], o[7]);
                    *(GAS v4u*)(HB + (size_t)(r0 + rr) * DM + AW + col) = w; }
            }
        }
    }
    GRID_BAR();
    {
        pg8::Gemm g{HB, WOUT_T, M, DM, DM}; pg8::StaticOrder S; S.init(M, DM, G, bx);
        pg8::EpiBf16SS E{YB, DM, SS};
        pg8::gemm_phase<pg8::EpiBf16SS, pg8::StaticOrder, true, true>(ldsb + RING_OFF, g, S, E);
    }
    GRID_BAR();
    { PHASE_IDS();
    for (int m = gw; m < M; m += NGW) { const int b = m / SEQ;
        const float ssy = wave_sum(SS[(size_t)m * 64 + lane]);
        const float rsy = 1.0f / sqrtf(ssy * (1.0f / DM) + EPS);
        const float* xr = args.x + (size_t)m * DM; const bf16* yr = YB + (size_t)m * DM; bf16* o1 = X1B + (size_t)m * DM;
        const float* G1 = VEC + (size_t)(2 * 4 + b) * DM; const float* A2 = VEC + (size_t)(4 * 4 + b) * DM; const float* SH2 = VEC + (size_t)(3 * 4 + b) * DM;
        f32x4 v[8][2]; float s = 0.f;
#pragma unroll
        for (int j = 0; j < 8; ++j) { const v4u yw = *(const GAS v4u*)(yr + 512 * j + 8 * lane);
#pragma unroll
            for (int h = 0; h < 2; ++h) { const int c = 512 * j + 8 * lane + 4 * h;
                const f32x4 xv = *(const f32x4*)(xr + c), gv = *(const f32x4*)(G1 + c);
                const f32x4 yv = h == 0 ? (f32x4){bflo(yw.x), bfhi(yw.x), bflo(yw.y), bfhi(yw.y)} : (f32x4){bflo(yw.z), bfhi(yw.z), bflo(yw.w), bfhi(yw.w)};
                const f32x4 x1 = xv + gv * yv * rsy; v[j][h] = x1;
                s += (x1[0] * x1[0] + x1[1] * x1[1]) + (x1[2] * x1[2] + x1[3] * x1[3]); }
            { v4u w; w.x = pk2(v[j][0][0], v[j][0][1]); w.y = pk2(v[j][0][2], v[j][0][3]); w.z = pk2(v[j][1][0], v[j][1][1]); w.w = pk2(v[j][1][2], v[j][1][3]); __builtin_nontemporal_store(w, (GAS v4u*)(o1 + 512 * j + 8 * lane)); } }
        const float rstd = 1.0f / sqrtf(wave_sum(s) * (1.0f / DM) + EPS);
        bf16* orow = HB + (size_t)m * DM;
#pragma unroll
        for (int j = 0; j < 8; ++j) { const int c = 512 * j + 8 * lane;
            const f32x4 a0 = *(const f32x4*)(A2 + c), a1 = *(const f32x4*)(A2 + c + 4), s0 = *(const f32x4*)(SH2 + c), s1 = *(const f32x4*)(SH2 + c + 4);
            const f32x4 q0 = v[j][0] * rstd * a0 + s0, q1 = v[j][1] * rstd * a1 + s1;
            v4u w; w.x = pk2(q0[0], q0[1]); w.y = pk2(q0[2], q0[3]); w.z = pk2(q1[0], q1[1]); w.w = pk2(q1[2], q1[3]);
            *(GAS v4u*)(orow + c) = w; }
    } }
    GRID_BAR();
    {
        pg8::Gemm g{HB, WUP_T, M, UPW, DM}; pg8::StaticOrder S; S.init(M, UPW, G, bx);
        pg8::EpiUp E{GB, args.w_conv_ffn, EDGE, ldsb + RING_OFF + 131072};
        pg8::gemm_phase<pg8::EpiUp, pg8::StaticOrder, true, true>(ldsb + RING_OFF, g, S, E);
        {   PHASE_IDS();
            constexpr int I_DN = (DFF / 64) * (DM / 64);
            const int rem = ((M / 256) * (UPW / 256)) % G, nh = rem == 0 ? G : G - rem, hid = rem == 0 ? bx : bx - rem;
            if (hid >= 0) { LAS unsigned* scr = (LAS unsigned*)(ldsb + RING_OFF + wave * 16384);
                for (int it = hid * NWAVES + wave; it < I_DN; it += nh * NWAVES) p0_transpose_item<0, true>(args.w_down, DFF, DM, WDN_T, scr, it, lane); }
        }
    }
    GRID_BAR();
    { PHASE_IDS();
    for (int i = gt; i < 64 * (DFF / 8); i += NGT) { const int kq = i / (DFF / 8), kb = 4 * kq, f = (i - kq * (DFF / 8)) * 8;
        const int cg = (f >> 7) * 256 + (f & 127);
        const bool hp = (kb & 63) != 0;
        const bf16* e = EDGE + (size_t)kb * 4 * UPW;
        const v4u zz = {0u, 0u, 0u, 0u};
        const v4u g0 = hp ? *(const GAS v4u*)(e + cg) : zz, g1 = hp ? *(const GAS v4u*)(e + UPW + cg) : zz, g2 = *(const GAS v4u*)(e + 2 * UPW + cg), g3 = *(const GAS v4u*)(e + 3 * UPW + cg);
        const v4u v0 = hp ? *(const GAS v4u*)(e + cg + 128) : zz, v1 = hp ? *(const GAS v4u*)(e + UPW + cg + 128) : zz, v2 = *(const GAS v4u*)(e + 2 * UPW + cg + 128), v3 = *(const GAS v4u*)(e + 3 * UPW + cg + 128);
        const float* wc = args.w_conv_ffn;
        unsigned oa[4], ob[4];
#pragma unroll
        for (int h = 0; h < 2; ++h) {
            const f32x4 wg0 = *(const f32x4*)(wc + f + 4 * h), wg1 = *(const f32x4*)(wc + UPW + f + 4 * h), wg2 = *(const f32x4*)(wc + 2 * UPW + f + 4 * h);
            const f32x4 wv0 = *(const f32x4*)(wc + DFF + f + 4 * h), wv1 = *(const f32x4*)(wc + UPW + DFF + f + 4 * h), wv2 = *(const f32x4*)(wc + 2 * UPW + DFF + f + 4 * h);
#define UNP4(w_) ((f32x4){bflo(h ? (w_).z : (w_).x), bfhi(h ? (w_).z : (w_).x), bflo(h ? (w_).w : (w_).y), bfhi(h ? (w_).w : (w_).y)})
            const f32x4 a0 = UNP4(g0), a1 = UNP4(g1), a2 = UNP4(g2), a3 = UNP4(g3), b0 = UNP4(v0), b1 = UNP4(v1), b2 = UNP4(v2), b3 = UNP4(v3);
#undef UNP4
            const f32x4 cga = wg0 * a0 + wg1 * a1 + wg2 * a2, cva = wv0 * b0 + wv1 * b1 + wv2 * b2;
            const f32x4 cgb = wg0 * a1 + wg1 * a2 + wg2 * a3, cvb = wv0 * b1 + wv1 * b2 + wv2 * b3;
            float pa[4], pb[4];
#pragma unroll
            for (int q = 0; q < 4; ++q) { pa[q] = pg8::silu_f(cga[q]) * cva[q]; pb[q] = pg8::silu_f(cgb[q]) * cvb[q]; }
            oa[2 * h] = pk2(pa[0], pa[1]); oa[2 * h + 1] = pk2(pa[2], pa[3]); ob[2 * h] = pk2(pb[0], pb[1]); ob[2 * h + 1] = pk2(pb[2], pb[3]);
        }
        bf16* ga = GB + (size_t)(f >> 6) * ((size_t)M * 64) + (size_t)(kb * 64) * 64 + (f & 63);
        { v4u w; w.x = oa[0]; w.y = oa[1]; w.z = oa[2]; w.w = oa[3]; *(GAS v4u*)ga = w; }
        { v4u w; w.x = ob[0]; w.y = ob[1]; w.z = ob[2]; w.w = ob[3]; *(GAS v4u*)(ga + 64) = w; } } }
    GRID_BAR();
    {
        pg8::Gemm g{GB, WDN_T, M, DM, DFF}; g.pa = 64; g.pb = 64; g.ksa = (long)M * 128; g.ksb = (long)DM * 128;
        pg8::StaticOrder S; S.init(M, DM, G, bx, WGM_P8);
        pg8::EpiBf16SS E{YB, DM, SS};
        pg8::gemm_phase<pg8::EpiBf16SS, pg8::StaticOrder, true, true>(ldsb + RING_OFF, g, S, E);
    }
    GRID_BAR();
    { PHASE_IDS();
    for (int m = gw; m < M; m += NGW) { const int b = m / SEQ;
        const float ssf = wave_sum(SS[(size_t)m * 64 + lane]);
        const float rsf = 1.0f / sqrtf(ssf * (1.0f / DM) + EPS);
        const bf16* fr_ = YB + (size_t)m * DM; const bf16* x1r = X1B + (size_t)m * DM; float* o1 = args.out + (size_t)m * DM; const float* G2 = VEC + (size_t)(5 * 4 + b) * DM;
#pragma unroll
        for (int j = 0; j < 8; ++j) { const v4u fw = *(const GAS v4u*)(fr_ + 512 * j + 8 * lane), xw = *(const GAS v4u*)(x1r + 512 * j + 8 * lane);
#pragma unroll
            for (int h = 0; h < 2; ++h) { const int c = 512 * j + 8 * lane + 4 * h;
                const f32x4 gv = *(const f32x4*)(G2 + c);
                const f32x4 xv = h == 0 ? (f32x4){bflo(xw.x), bfhi(xw.x), bflo(xw.y), bfhi(xw.y)} : (f32x4){bflo(xw.z), bfhi(xw.z), bflo(xw.w), bfhi(xw.w)};
                const f32x4 fv = h == 0 ? (f32x4){bflo(fw.x), bfhi(fw.x), bflo(fw.y), bfhi(fw.y)} : (f32x4){bflo(fw.z), bfhi(fw.z), bflo(fw.w), bfhi(fw.w)};
                *(f32x4*)(o1 + c) = xv + gv * fv * rsf; } }
    } }
}

extern "C" void kernel_launch(void* const* d_in, const int* in_sizes, int n_in, void* d_out, int out_size, void* d_ws, size_t ws_size, hipStream_t stream) {
    static int grid = 0;
    if (grid == 0) {
        if (n_in != 20 || in_sizes[0] != M * DM || out_size != M * DM || ws_size < WS_END) { fprintf(stderr, "kernel_launch: shape/workspace mismatch: n_in %d in0 %d out %d ws %zu (need %zu); nothing launched\n", n_in, n_in > 0 ? in_sizes[0] : -1, out_size, ws_size, (size_t)WS_END); grid = -1; return; }
        int dev = 0, cus = 0, per_cu = 0;
        if (hipGetDevice(&dev) != hipSuccess || hipDeviceGetAttribute(&cus, hipDeviceAttributeMultiprocessorCount, dev) != hipSuccess) { fprintf(stderr, "kernel_launch: device query failed\n"); grid = -1; return; }
        if (hipFuncSetAttribute((const void*)fwd_kernel, hipFuncAttributeMaxDynamicSharedMemorySize, LDS_BYTES) != hipSuccess) { fprintf(stderr, "kernel_launch: hipFuncSetAttribute failed\n"); grid = -1; return; }
        if (hipOccupancyMaxActiveBlocksPerMultiprocessor(&per_cu, (const void*)fwd_kernel, NWAVES * 64, LDS_BYTES) != hipSuccess || per_cu < 1)
            fprintf(stderr, "kernel_launch: note: occupancy query reports %d workgroups per CU\n", per_cu);
        (void)hipGetLastError();
        grid = cus;
    }
    if (grid < 0) return;
    if (hipMemsetAsync((char*)d_ws + WS_CTL, 0, CTL_ZERO_BYTES, stream) != hipSuccess) { fprintf(stderr, "kernel_launch: memset failed\n"); return; }
    Args a{};
    a.x = (const float*)d_in[0]; a.c = (const float*)d_in[1]; a.pos = (const int*)d_in[2]; a.w_ada = (const float*)d_in[3]; a.b_ada = (const float*)d_in[4];
    a.g_pre_mix = (const float*)d_in[5]; a.g_post_mix = (const float*)d_in[6]; a.w_in = (const float*)d_in[7];
    a.lq1 = (const float*)d_in[8]; a.lk1 = (const float*)d_in[9]; a.lq2 = (const float*)d_in[10]; a.lk2 = (const float*)d_in[11];
    a.g_subln = (const float*)d_in[12]; a.w_conv_mix = (const float*)d_in[13]; a.w_out = (const float*)d_in[14];
    a.g_pre_ffn = (const float*)d_in[15]; a.g_post_ffn = (const float*)d_in[16]; a.w_up = (const float*)d_in[17]; a.w_conv_ffn = (const float*)d_in[18]; a.w_down = (const float*)d_in[19];
    a.out = (float*)d_out; a.ws = (unsigned char*)d_ws;
    hipLaunchKernelGGL(fwd_kernel, dim3(grid), dim3(NWAVES * 64), LDS_BYTES, stream, a);
    const hipError_t le = hipPeekAtLastError();
    if (le != hipSuccess) fprintf(stderr, "kernel_launch: launch failed: %s\n", hipGetErrorName(le));
}
```
